# Optimizing an MI355X kernel written in HIP

```python
import math
import jax, jax.numpy as jnp
from jax import lax
import numpy as np

D_MODEL = 1024
BATCH = 16
SEQ = 2048
DEPTH = 4
DEC_BATCH = 32
DEC_SEQ = 16
PAST_LEN = 2048

CHUNK = 64
N_PAST_CHUNKS = 8
BAND = (N_PAST_CHUNKS + 1) * CHUNK
HEAD_DIM = 64
ATT_W = D_MODEL // 2
N_HEADS = ATT_W // HEAD_DIM
CONV_CH = D_MODEL - ATT_W
N_CONV_GROUPS = CONV_CH // HEAD_DIM
MIX_W = ATT_W + CONV_CH
PROJ_W = 3 * ATT_W + 3 * CONV_CH
CONV_W = 3
REL_CLIP = 128
D_FF = ((8 * D_MODEL // 3 + 127) // 128) * 128
EPS = 1e-6
NEG_INF = -1e30
SCALE = HEAD_DIM ** -0.5

kernel_name = "hybrid_streaming_encoder_step"


def rmsnorm(x, g):
    xf = x.astype(jnp.float32)
    y = xf * lax.rsqrt(jnp.mean(xf * xf, axis=-1, keepdims=True) + EPS)
    return (y * g.astype(jnp.float32)).astype(x.dtype)


def group_rmsnorm(x, g, groups):
    shp = x.shape
    xf = x.astype(jnp.float32).reshape(shp[:-1] + (groups, shp[-1] // groups))
    y = xf * lax.rsqrt(jnp.mean(xf * xf, axis=-1, keepdims=True) + EPS)
    return (y.reshape(shp) * g.astype(jnp.float32)).astype(x.dtype)


def causal_dwconv(u_ext, w):
    T = u_ext.shape[1] - (CONV_W - 1)
    out = w[0] * u_ext[:, 0:T]
    for i in range(1, CONV_W):
        out = out + w[i] * u_ext[:, i:i + T]
    return out


def rel_bias(table, q_off, k_off):
    idx = jnp.clip(q_off[:, None] - k_off[None, :], -REL_CLIP, REL_CLIP) + REL_CLIP
    return table[:, idx]


def band_softmax(qc, kb, vb, bias, mask):
    s = jnp.einsum('bcqhd,bckhd->bchqk', qc, kb).astype(jnp.float32) + bias.astype(jnp.float32)
    s = jnp.where(mask[None, :, None, None, :], s, NEG_INF)
    p = jax.nn.softmax(s, axis=-1).astype(vb.dtype)
    return jnp.einsum('bchqk,bckhd->bcqhd', p, vb)


def chunk_band_attention(q, k, v, table):
    Bn, T, H, Dh = q.shape
    nc = T // CHUNK
    qc = (q * SCALE).reshape(Bn, nc, CHUNK, H, Dh)
    pad = jnp.zeros((Bn, N_PAST_CHUNKS, CHUNK, H, Dh), k.dtype)

    def band(t):
        tp = jnp.concatenate([pad, t.reshape(Bn, nc, CHUNK, H, Dh)], axis=1)
        return jnp.concatenate([tp[:, s:s + nc] for s in range(N_PAST_CHUNKS + 1)], axis=2)

    kb, vb = band(k), band(v)
    k_off = jnp.arange(BAND) - N_PAST_CHUNKS * CHUNK
    bias = rel_bias(table, jnp.arange(CHUNK), k_off)
    slot_ok = (jnp.arange(nc)[:, None] + jnp.arange(N_PAST_CHUNKS + 1)[None, :]) >= N_PAST_CHUNKS
    mask = jnp.repeat(slot_ok, CHUNK, axis=1)
    out = band_softmax(qc, kb, vb, bias, mask)
    return out.reshape(Bn, T, H * Dh)


def cached_band_attention(q, k, v, table, ck, cv):
    Bn, Tn, H, Dh = q.shape
    Lc = ck.shape[1]
    kb = jnp.concatenate([ck, k], axis=1)[:, None]
    vb = jnp.concatenate([cv, v], axis=1)[:, None]
    k_off = jnp.arange(Lc + Tn) - Lc
    bias = rel_bias(table, jnp.arange(Tn), k_off)
    mask = jnp.ones((1, Lc + Tn), dtype=bool)
    out = band_softmax((q * SCALE)[:, None], kb, vb, bias, mask)
    return out.reshape(Bn, Tn, H * Dh)


def trunk_layer(x, attn_fn, conv_hist, ffn_hist, ln1, w_in, rel_table, conv_w, attn_g, conv_g,
                w_out, ln2, w_up, fconv_w, fconv_b, w_down):
    Bn, T, _ = x.shape
    h = rmsnorm(x, ln1)
    proj = h @ w_in
    q = proj[..., 0:ATT_W].reshape(Bn, T, N_HEADS, HEAD_DIM)
    k = proj[..., ATT_W:2 * ATT_W].reshape(Bn, T, N_HEADS, HEAD_DIM)
    v = proj[..., 2 * ATT_W:3 * ATT_W].reshape(Bn, T, N_HEADS, HEAD_DIM)
    o = 3 * ATT_W
    bg = proj[..., o:o + CONV_CH]
    cg = proj[..., o + CONV_CH:o + 2 * CONV_CH]
    hv = proj[..., o + 2 * CONV_CH:o + 3 * CONV_CH]
    att = attn_fn(q, k, v, rel_table)
    u_ext = jnp.concatenate([conv_hist, cg * hv], axis=1)
    z = bg * causal_dwconv(u_ext, conv_w)
    mixed = jnp.concatenate([group_rmsnorm(att, attn_g, N_HEADS),
                             group_rmsnorm(z, conv_g, N_CONV_GROUPS)], axis=-1) @ w_out
    x = x + mixed
    up = rmsnorm(x, ln2) @ w_up
    up_ext = jnp.concatenate([ffn_hist, up], axis=1)
    a = causal_dwconv(up_ext, fconv_w) + fconv_b
    x = x + (jax.nn.silu(a[..., :D_FF]) * a[..., D_FF:]) @ w_down
    return x, k, v, u_ext[:, -(CONV_W - 1):], up_ext[:, -(CONV_W - 1):]


def setup_inputs(seed: int = 0) -> dict:
    key = jax.random.key(seed)
    ks = jax.random.split(key, 24)
    f32 = jnp.float32
    att_cache = min(N_PAST_CHUNKS * CHUNK, PAST_LEN)
    n = lambda i, shape, s: jax.random.normal(ks[i], shape, f32) * s
    return {
        "x_prompt": n(0, (BATCH, SEQ, D_MODEL), 1.0),
        "x_sample": n(1, (DEC_BATCH, DEC_SEQ, D_MODEL), 1.0),
        "cache_attn_k": n(2, (DEPTH, DEC_BATCH, att_cache, N_HEADS, HEAD_DIM), 1.0),
        "cache_attn_v": n(3, (DEPTH, DEC_BATCH, att_cache, N_HEADS, HEAD_DIM), 1.0),
        "state_mix_conv": n(4, (DEPTH, DEC_BATCH, CONV_W - 1, CONV_CH), 1.0),
        "state_ffn_conv": n(5, (DEPTH, DEC_BATCH, CONV_W - 1, 2 * D_FF), 1.0),
        "ln1": 1.0 + n(6, (DEPTH, D_MODEL), 0.02),
        "w_in": n(7, (DEPTH, D_MODEL, PROJ_W), D_MODEL ** -0.5),
        "rel_table": n(8, (DEPTH, N_HEADS, 2 * REL_CLIP + 1), 0.2),
        "conv_w": n(9, (DEPTH, CONV_W, CONV_CH), CONV_W ** -0.5),
        "attn_g": 1.0 + n(10, (DEPTH, ATT_W), 0.02),
        "conv_g": 1.0 + n(11, (DEPTH, CONV_CH), 0.02),
        "w_out": n(12, (DEPTH, MIX_W, D_MODEL), MIX_W ** -0.5),
        "ln2": 1.0 + n(13, (DEPTH, D_MODEL), 0.02),
        "w_up": n(14, (DEPTH, D_MODEL, 2 * D_FF), D_MODEL ** -0.5),
        "fconv_w": n(15, (DEPTH, CONV_W, 2 * D_FF), CONV_W ** -0.5),
        "fconv_b": n(16, (DEPTH, 2 * D_FF), 0.01),
        "w_down": n(17, (DEPTH, D_FF, D_MODEL), D_FF ** -0.5),
        "final_norm": 1.0 + n(18, (D_MODEL,), 0.02),
    }


def reference(x_prompt, x_sample, cache_attn_k, cache_attn_v, state_mix_conv, state_ffn_conv,
              ln1, w_in, rel_table, conv_w, attn_g, conv_g, w_out, ln2, w_up, fconv_w, fconv_b,
              w_down, final_norm):
    Bp, Tp, _ = x_prompt.shape
    keep = min(N_PAST_CHUNKS * CHUNK, Tp)
    xp, xs = x_prompt, x_sample
    kp_l, vp_l, cp_l, fp_l = [], [], [], []
    ks_l, vs_l, cs_l, fs_l = [], [], [], []
    for l in range(DEPTH):
        w = (ln1[l], w_in[l], rel_table[l], conv_w[l], attn_g[l], conv_g[l], w_out[l],
             ln2[l], w_up[l], fconv_w[l], fconv_b[l], w_down[l])
        zc = jnp.zeros((Bp, CONV_W - 1, CONV_CH), xp.dtype)
        zf = jnp.zeros((Bp, CONV_W - 1, 2 * D_FF), xp.dtype)
        xp, kp, vp, cp, fp = trunk_layer(xp, chunk_band_attention, zc, zf, *w)
        kp_l.append(kp[:, Tp - keep:])
        vp_l.append(vp[:, Tp - keep:])
        cp_l.append(cp)
        fp_l.append(fp)
        ck, cv = cache_attn_k[l], cache_attn_v[l]
        samp_attn = lambda q, k, v, t, ck=ck, cv=cv: cached_band_attention(q, k, v, t, ck, cv)
        xs, kk, vv, cs, fs = trunk_layer(xs, samp_attn, state_mix_conv[l], state_ffn_conv[l], *w)
        ks_l.append(kk)
        vs_l.append(vv)
        cs_l.append(cs)
        fs_l.append(fs)
    y_prompt = rmsnorm(xp, final_norm)
    y_sample = rmsnorm(xs, final_norm)
    return (y_prompt, y_sample,
            jnp.stack(kp_l), jnp.stack(vp_l), jnp.stack(cp_l), jnp.stack(fp_l),
            jnp.stack(ks_l), jnp.stack(vs_l), jnp.stack(cs_l), jnp.stack(fs_l))
```

```cpp
#ifndef PH
#define PH 127
#endif
#include <hip/hip_runtime.h>
#include <hip/hip_cooperative_groups.h>
#include <cstdio>
#include <cstdint>
namespace cg = cooperative_groups;

#define LAS __attribute__((address_space(3)))
#define PG8_LAS LAS
typedef unsigned short bf16_t;
typedef short bf16x8 __attribute__((ext_vector_type(8)));
typedef float f32x4 __attribute__((ext_vector_type(4)));
typedef float f32x16 __attribute__((ext_vector_type(16)));
typedef unsigned u32x4 __attribute__((ext_vector_type(4)));
typedef unsigned u32x2 __attribute__((ext_vector_type(2)));

constexpr int DM = 1024, NB = 16, SEQ = 2048, DEPTH = 4, SB = 32, SS = 16;
constexpr int NP = NB * SEQ, NS = SB * SS, M = NP + NS, MP = 33792;
constexpr int PW = 2560, PROJ = 3072, DFF = 2816, UPW = 5632, LDV = MP;
constexpr float EPS = 1e-6f, LOG2E = 1.4426950408889634f;
constexpr size_t O_Y = 0;
constexpr size_t O_KP = (size_t)M * DM;
constexpr size_t O_VP = O_KP + (size_t)DEPTH * NB * 512 * 512;
constexpr size_t O_CP = O_VP + (size_t)DEPTH * NB * 512 * 512;
constexpr size_t O_FP = O_CP + (size_t)DEPTH * NB * 2 * 512;
constexpr size_t O_KS = O_FP + (size_t)DEPTH * NB * 2 * UPW;
constexpr size_t O_VS = O_KS + (size_t)DEPTH * SB * SS * 512;
constexpr size_t O_CS = O_VS + (size_t)DEPTH * SB * SS * 512;
constexpr size_t O_FS = O_CS + (size_t)DEPTH * SB * 2 * 512;
constexpr size_t MiB = 1u << 20;
constexpr size_t WS_CTL = 0;
constexpr size_t WS_W = 1 * MiB;
constexpr size_t W_IN = 0, W_OUT = 6 * MiB, W_UP = 8 * MiB, W_DOWN = 19 * MiB, W_LAYER = 25 * MiB;
constexpr size_t WS_XG = WS_W + 4 * W_LAYER;
constexpr size_t WS_SSQ = WS_XG + 66 * MiB;
constexpr size_t WS_P5 = WS_SSQ + 3 * MiB;
constexpr size_t WS_VT = WS_P5 + 165 * MiB;
constexpr size_t WS_ACT = WS_P5;
constexpr size_t WS_MIX = WS_VT + 33 * MiB;
constexpr size_t WS_KC = WS_MIX + 66 * MiB;
constexpr size_t WS_VCT = WS_KC + 16 * MiB;
constexpr size_t WS_FIRST = WS_VCT + 16 * MiB;
constexpr size_t WS_LAST = WS_FIRST + 6 * MiB;
constexpr size_t WS_KF = WS_LAST + 6 * MiB;
constexpr size_t WS_PART = WS_KF + 34 * MiB;
constexpr size_t WS_END = WS_PART + 22 * MiB;
static_assert((size_t)MP * 2816 * 2 <= (size_t)198 * MiB, "ACT overlay");
constexpr int LDS_BYTES = 156160, EXTRA_OFF = 131072;
constexpr int X_PRE = 8448, X_W = 16640, X_BAR = 24832;

__device__ __forceinline__ unsigned cvt_pk_bf16(float lo, float hi) { unsigned r; asm volatile("v_cvt_pk_bf16_f32 %0, %1, %2" : "=v"(r) : "v"(lo), "v"(hi)); return r; }
__device__ __forceinline__ float bf2f(unsigned short b) { return __builtin_bit_cast(float, (unsigned)b << 16); }
__device__ __forceinline__ float rstd_of(f32x4 p) { return rsqrtf(((p.x + p.y) + (p.z + p.w)) * (1.0f / 1024.0f) + EPS); }
template <int CTRL> __device__ __forceinline__ float dppf(float old, float src) {
    return __builtin_bit_cast(float, __builtin_amdgcn_update_dpp(__builtin_bit_cast(int, old), __builtin_bit_cast(int, src), CTRL, 0xf, 0xf, false));
}

typedef const __attribute__((address_space(4))) char* kargp_t;
__device__ __forceinline__ const float* karg(int k) { kargp_t p = (kargp_t)__builtin_amdgcn_kernarg_segment_ptr(); asm volatile("" : "+s"(p)); return *(const float* const __attribute__((address_space(4)))*)(p + 8 * k); }
namespace pg8 {
constexpr int BM = 256, BK = 64, HALF = 128, HTB = HALF * BK * 2, STAGE_BYTES = 8 * HTB, NXCD = 8, WGM = 4;
__host__ __device__ __forceinline__ int lds_byte(int r, int c) { const int st = (r >> 4) * 2 + (c >> 5), rr = r & 15, cc = c & 31, ob = rr * 64 + cc * 2; return st * 1024 + (ob ^ (((ob >> 9) & 1) << 5)); }
__host__ __device__ __forceinline__ void stage_rc(int b, int& R, int& C) { const int st = b / 1024, sb = b % 1024, swz = sb ^ (((sb >> 9) & 1) << 5); R = (st >> 1) * 16 + swz / 64; C = (st & 1) * 32 + (swz % 64) / 2; }
__host__ __device__ __forceinline__ int perm32(int rho) { const int n = rho >> 4, i = rho & 15; return 8 * (i >> 2) + 4 * n + (i & 3); }
struct Unit { int pm, pn, kind, nt; int slice, nsplit, tile, pad; const char* a; const char* b; };
__device__ __forceinline__ void map_tile(int L, int nM, int nN, int& pm, int& pn) {
    const int nwg = nM * nN; int wgid = L;
    { const int q = nwg / NXCD, r = nwg % NXCD, xcd = wgid % NXCD, off = wgid / NXCD; wgid = (xcd < r ? xcd * (q + 1) : r * (q + 1) + (xcd - r) * q) + off; }
    const int nig = WGM * nN, gid = wgid / nig, fm = gid * WGM, gsz = (nM - fm) < WGM ? (nM - fm) : WGM;
    pm = fm + ((wgid % nig) % gsz); pn = (wgid % nig) / gsz;
}
template <class Epi, class Sched, bool ALIGN_EPI = false, bool SP2 = false>
__device__ __forceinline__ void gemm_phase(PG8_LAS unsigned char* lds, const int Kdim, const Sched& S, const Epi& E) {
    int tid_o = threadIdx.x; asm volatile("" : "+v"(tid_o));
    const int tid = tid_o, wid = __builtin_amdgcn_readfirstlane(tid >> 6), lane = tid & 63, wr = wid >> 2, wc = wid & 3, fr = lane & 15, fq = lane >> 4;
    const int K = Kdim;
    unsigned voffA[2], voffB[2]; int aoff, boff;
#define PG8_ADDR_SETUP(t_) do { _Pragma("unroll") for (int i = 0; i < 2; ++i) { int R, C; stage_rc((t_) * 16 + i * 8192, R, C); const int Rb = Epi::PERM ? ((R & ~31) + perm32(R & 31)) : R; \
        voffA[i] = (unsigned)(R * K + C) * 2u; voffB[i] = (unsigned)(Rb * K + C) * 2u; } \
        aoff = lds_byte(wr * 64 + ((t_) & 15), (((t_) & 63) >> 4) * 8); boff = lds_byte(wc * 32 + ((t_) & 15), (((t_) & 63) >> 4) * 8); } while (0)
    PG8_ADDR_SETUP(tid);
    const size_t kstep = (size_t)(BK * 2);
    const size_t hstep = (size_t)HALF * K * 2;
    const size_t tstep = 2 * hstep;
    const unsigned ldsw = (unsigned)wid * 1024u;
#define PG8_SA(b, h) (((b) * 2 + (h)) * HTB)
#define PG8_SB(b, h) ((4 + (b) * 2 + (h)) * HTB)
#define PG8_STAGE(bufoff, gbase, voff) do { _Pragma("unroll") for (int _i = 0; _i < 2; ++_i) \
        __builtin_amdgcn_global_load_lds((const unsigned*)((const char*)(gbase) + (voff)[_i]), (PG8_LAS unsigned*)(lds + (bufoff) + ldsw + _i * 8192), 16, 0, 0); } while (0)
#define PG8_LDA(dst, b, h) do { _Pragma("unroll") for (int m = 0; m < 4; ++m) _Pragma("unroll") for (int k = 0; k < 2; ++k) dst[m][k] = *(const PG8_LAS bf16x8*)(lds + PG8_SA(b, h) + aoff + m * 2048 + k * 1024); } while (0)
#define PG8_LDB(dst, b, h) do { _Pragma("unroll") for (int n = 0; n < 2; ++n) _Pragma("unroll") for (int k = 0; k < 2; ++k) dst[n][k] = *(const PG8_LAS bf16x8*)(lds + PG8_SB(b, h) + boff + n * 2048 + k * 1024); } while (0)
#define PG8_MMA(ai, bj, At, Bt) do { __builtin_amdgcn_s_setprio(1); _Pragma("unroll") for (int m = 0; m < 4; ++m) _Pragma("unroll") for (int n = 0; n < 2; ++n) _Pragma("unroll") for (int k = 0; k < 2; ++k) \
        acc[ai][bj][m][n] = __builtin_amdgcn_mfma_f32_16x16x32_bf16(Bt[n][k], At[m][k], acc[ai][bj][m][n], 0, 0, 0); __builtin_amdgcn_s_setprio(0); } while (0)
#define PG8_WAIT_V(n) asm volatile("s_waitcnt vmcnt(" #n ")" ::: "memory")
#define PG8_WAIT_L(n) asm volatile("s_waitcnt lgkmcnt(" #n ")" ::: "memory")
#define PG8_BAR __builtin_amdgcn_s_barrier()
#define PG8_SCHED __builtin_amdgcn_sched_barrier(0)
    Unit cur, nxt; int ui = 0;
    if (!S.next(0, cur)) return;
    E.pre_issue(cur, 0, wid, lane, lds);
    f32x4 acc[2][2][4][2];
#pragma unroll
    for (int a = 0; a < 2; ++a)
#pragma unroll
        for (int b = 0; b < 2; ++b)
#pragma unroll
            for (int m = 0; m < 4; ++m)
#pragma unroll
                for (int n = 0; n < 2; ++n) acc[a][b][m][n] = (f32x4){0.f, 0.f, 0.f, 0.f};
    bf16x8 At[4][2], B0[2][2], B1[2][2];
    const char* cA = cur.a; const char* cB = cur.b;

    if constexpr (SP2) {
        PG8_STAGE(PG8_SB(0, 0), cB, voffB); PG8_STAGE(PG8_SB(0, 1), cB + hstep, voffB); PG8_STAGE(PG8_SA(0, 0), cA, voffA); PG8_STAGE(PG8_SA(0, 1), cA + hstep, voffA);
        if (wr == 1) PG8_BAR;
        PG8_WAIT_V(2); PG8_BAR;
        PG8_STAGE(PG8_SB(1, 0), cB + kstep, voffB); PG8_STAGE(PG8_SA(1, 0), cA + kstep, voffA); PG8_STAGE(PG8_SB(1, 1), cB + hstep + kstep, voffB);
        PG8_WAIT_V(6); PG8_BAR;
    } else {
        PG8_STAGE(PG8_SB(0, 0), cB, voffB); PG8_STAGE(PG8_SA(0, 0), cA, voffA); PG8_STAGE(PG8_SB(0, 1), cB + hstep, voffB); PG8_STAGE(PG8_SA(0, 1), cA + hstep, voffA);
        if (wr == 1) PG8_BAR;
        PG8_WAIT_V(4); PG8_BAR;
        PG8_STAGE(PG8_SB(1, 0), cB + kstep, voffB); PG8_STAGE(PG8_SA(1, 0), cA + kstep, voffA); PG8_STAGE(PG8_SB(1, 1), cB + hstep + kstep, voffB);
        PG8_WAIT_V(6); PG8_BAR;
    }
    for (;;) {
        const bool has_next = S.next(ui + 1, nxt);
        const char* nA = has_next ? nxt.a : cA; const char* nB = has_next ? nxt.b : cB;
        const int nt = cur.nt;
        for (int t = 0; t < nt; t += 2) {
            const bool last = (t == nt - 2);
            const char* a1 = cA + (size_t)(t + 1) * kstep;
            const char* a2 = last ? nA : cA + (size_t)(t + 2) * kstep; const char* b2 = last ? nB : cB + (size_t)(t + 2) * kstep;
            const char* a3 = a2 + kstep; const char* b3 = b2 + kstep;

            if constexpr (SP2) {
            PG8_LDB(B0, 0, 0); PG8_LDB(B1, 0, 1); PG8_SCHED; PG8_LDA(At, 0, 0); PG8_STAGE(PG8_SA(1, 1), a1 + hstep, voffA);
            PG8_WAIT_V(8); PG8_WAIT_L(0); PG8_BAR; PG8_MMA(0, 0, At, B0); PG8_MMA(0, 1, At, B1); PG8_BAR; PG8_SCHED;
            PG8_LDA(At, 0, 1); PG8_STAGE(PG8_SB(0, 0), b2, voffB); PG8_STAGE(PG8_SB(0, 1), b2 + hstep, voffB); PG8_STAGE(PG8_SA(0, 0), a2, voffA);
            PG8_WAIT_V(8); PG8_WAIT_L(0); PG8_BAR; PG8_MMA(1, 0, At, B0); PG8_MMA(1, 1, At, B1); PG8_BAR; PG8_SCHED;
            PG8_LDB(B0, 1, 0); PG8_LDB(B1, 1, 1); PG8_SCHED; PG8_LDA(At, 1, 0); PG8_STAGE(PG8_SA(0, 1), a2 + hstep, voffA);
            PG8_WAIT_V(8); PG8_WAIT_L(0); PG8_BAR; PG8_MMA(0, 0, At, B0); PG8_MMA(0, 1, At, B1); PG8_BAR; PG8_SCHED;
            PG8_LDA(At, 1, 1); PG8_STAGE(PG8_SB(1, 0), b3, voffB); PG8_STAGE(PG8_SB(1, 1), b3 + hstep, voffB); PG8_STAGE(PG8_SA(1, 0), a3, voffA);
            PG8_WAIT_V(8); PG8_WAIT_L(0); PG8_BAR; PG8_MMA(1, 0, At, B0); PG8_MMA(1, 1, At, B1); PG8_BAR; PG8_SCHED;
            } else {
            PG8_LDB(B0, 0, 0); PG8_SCHED; PG8_LDA(At, 0, 0); PG8_STAGE(PG8_SA(1, 1), a1 + hstep, voffA);
            PG8_WAIT_L(8); PG8_BAR; PG8_WAIT_L(0); PG8_MMA(0, 0, At, B0); PG8_BAR; PG8_SCHED;
            PG8_LDB(B1, 0, 1); PG8_STAGE(PG8_SB(0, 0), b2, voffB);
            PG8_BAR; PG8_WAIT_L(0); PG8_MMA(0, 1, At, B1); PG8_BAR;
            PG8_LDA(At, 0, 1); PG8_STAGE(PG8_SA(0, 0), a2, voffA);
            PG8_BAR; PG8_WAIT_L(0); PG8_MMA(1, 0, At, B0); PG8_BAR; PG8_SCHED;
            PG8_STAGE(PG8_SB(0, 1), b2 + hstep, voffB);
            PG8_WAIT_V(6); PG8_BAR; PG8_MMA(1, 1, At, B1); PG8_BAR;
            PG8_LDB(B0, 1, 0); PG8_SCHED; PG8_LDA(At, 1, 0); PG8_STAGE(PG8_SA(0, 1), a2 + hstep, voffA);
            PG8_WAIT_L(8); PG8_BAR; PG8_WAIT_L(0); PG8_MMA(0, 0, At, B0); PG8_BAR; PG8_SCHED;
            PG8_LDB(B1, 1, 1); PG8_STAGE(PG8_SB(1, 0), b3, voffB);
            PG8_BAR; PG8_WAIT_L(0); PG8_MMA(0, 1, At, B1); PG8_BAR;
            PG8_LDA(At, 1, 1); PG8_STAGE(PG8_SA(1, 0), a3, voffA);
            PG8_BAR; PG8_WAIT_L(0); PG8_MMA(1, 0, At, B0); PG8_BAR; PG8_SCHED;
            PG8_STAGE(PG8_SB(1, 1), b3 + hstep, voffB);
            PG8_WAIT_V(6); PG8_BAR; PG8_MMA(1, 1, At, B1); PG8_BAR;
            }
        }
        if constexpr (ALIGN_EPI) { if (wr == 0) PG8_BAR; }
        bool do_epi = true;
        if (cur.nsplit > 1) {
            float* part = (float*)((unsigned char*)karg(20) + WS_PART);
            unsigned* cnt = (unsigned*)((unsigned char*)karg(20) + WS_CTL + 32768) + S.cbase + cur.tile;
            f32x4* mine = (f32x4*)(part + ((size_t)cur.tile * 2 + cur.slice) * 65536) + tid;
#pragma unroll
            for (int a = 0; a < 2; ++a)
#pragma unroll
                for (int b = 0; b < 2; ++b)
#pragma unroll
                    for (int m = 0; m < 4; ++m) {
#pragma unroll
                        for (int n = 0; n < 2; ++n) { f32x4* p_ = mine + (((a * 2 + b) * 4 + m) * 2 + n) * 512; asm volatile("global_store_dwordx4 %0, %1, off sc1\n\ts_nop 1" :: "v"(p_), "v"(acc[a][b][m][n]) : "memory"); }
                        __builtin_amdgcn_sched_barrier(0);
                    }
            asm volatile("s_waitcnt vmcnt(0)" ::: "memory");
            PG8_BAR;
            LAS unsigned* flag = (LAS unsigned*)(lds + EXTRA_OFF + 8192 + 64);
            if (tid == 0) {
                const unsigned old = __hip_atomic_fetch_add(cnt, 1u, __ATOMIC_RELAXED, __HIP_MEMORY_SCOPE_AGENT);
                if (old == 1u) { __builtin_amdgcn_fence(__ATOMIC_ACQUIRE, "agent"); asm volatile("s_waitcnt vmcnt(0)" ::: "memory"); }
                *flag = old;
            }
            asm volatile("s_waitcnt lgkmcnt(0)" ::: "memory");
            PG8_BAR;
            const unsigned old = *flag;
            asm volatile("s_waitcnt lgkmcnt(0)" ::: "memory");
            PG8_BAR;
            do_epi = (old == 1u);
            if (do_epi) {
                const f32x4* oth = (const f32x4*)(part + ((size_t)cur.tile * 2 + (cur.slice ^ 1)) * 65536) + tid;
#pragma unroll
                for (int a = 0; a < 2; ++a)
#pragma unroll
                    for (int b = 0; b < 2; ++b) {
#pragma unroll
                        for (int m = 0; m < 4; ++m)
#pragma unroll
                            for (int n = 0; n < 2; ++n) acc[a][b][m][n] += oth[(((a * 2 + b) * 4 + m) * 2 + n) * 512];
                        __builtin_amdgcn_sched_barrier(0);
                    }
            }
        }
        if (do_epi) E(acc, cur, ui, wr, wc, fr, fq, lane, lds);
        if (!has_next) break;
#pragma unroll
        for (int a = 0; a < 2; ++a)
#pragma unroll
            for (int b = 0; b < 2; ++b)
#pragma unroll
                for (int m = 0; m < 4; ++m)
#pragma unroll
                    for (int n = 0; n < 2; ++n) acc[a][b][m][n] = (f32x4){0.f, 0.f, 0.f, 0.f};
        cur = nxt; cA = nA; cB = nB; ++ui;
        asm volatile("s_waitcnt lgkmcnt(0)" ::: "memory"); E.pre_issue(cur, ui, wid, lane, lds);
        { int t2 = threadIdx.x; asm volatile("" : "+v"(t2)); PG8_ADDR_SETUP(t2); }
        if constexpr (ALIGN_EPI) { if (wr == 1) PG8_BAR; }
    }
    PG8_WAIT_V(0);
    if constexpr (!ALIGN_EPI) { if (wr == 0) PG8_BAR; }
    PG8_BAR;

#undef PG8_ADDR_SETUP
#undef PG8_SA
#undef PG8_SB
#undef PG8_STAGE
#undef PG8_LDA
#undef PG8_LDB
#undef PG8_MMA
#undef PG8_WAIT_V
#undef PG8_WAIT_L
#undef PG8_BAR
#undef PG8_SCHED
}
}
using pg8::Unit;
__device__ __forceinline__ void pre_rows(const float* ssq4, int rowbase, int ui, int wid, int lane, LAS unsigned char* lds) {
    LAS unsigned* dst = (LAS unsigned*)(lds + EXTRA_OFF + X_PRE) + (ui & 1) * 1024 + wid * 128;
    const float* src = ssq4 + ((ptrdiff_t)rowbase + wid * 32) * 4 + lane;
    __builtin_amdgcn_global_load_lds((const unsigned*)src, dst, 4, 0, 0);
    __builtin_amdgcn_global_load_lds((const unsigned*)(src + 64), dst + 64, 4, 0, 0);
}
constexpr size_t TSTEP1K = (size_t)256 * 1024 * 2;
struct SchedGemm {
    const char* A; const char* Bt; int nN, G, c, nt, S, cbase; size_t tstep;
    __device__ __forceinline__ bool next(int i, Unit& u) const {
        long L = (long)i * G + c; const int npr = 128 * nN;
        u.kind = 0; u.pad = 0;
        if (L < npr) { pg8::map_tile((int)L, 128, nN, u.pm, u.pn); u.nt = nt; u.slice = 0; u.nsplit = 1; u.tile = 0; u.a = A + (size_t)u.pm * tstep; u.b = Bt + (size_t)u.pn * tstep; return true; }
        L -= npr; if (L >= 2 * nN * S) return false;
        const int tile = (int)(L / S), sl = (int)(L % S), nts = nt / S;
        u.pm = 128 + (tile & 1); u.pn = tile >> 1; u.nt = nts; u.slice = sl; u.nsplit = S; u.tile = tile;
        u.a = A + (size_t)u.pm * tstep + (size_t)sl * nts * 128; u.b = Bt + (size_t)u.pn * tstep + (size_t)sl * nts * 128; return true;
    }
};
struct SchedIn {
    const char* XG; const char* Wmain; const char* Wv; int G, c, cbase;
    __device__ __forceinline__ bool next(int i, Unit& u) const {
        long L = (long)i * G + c;
        u.pad = 0; u.nt = 16; u.slice = 0; u.nsplit = 1; u.tile = 0;
        if (L < 1280) { pg8::map_tile((int)L, 128, 10, u.pm, u.pn); u.kind = 0; u.a = XG + (size_t)u.pm * TSTEP1K; u.b = Wmain + (size_t)u.pn * TSTEP1K; return true; }
        L -= 1280;
        if (L < 256) { u.pm = (int)(L >> 7); u.pn = (int)(L & 127); u.kind = 1;     u.a = Wv + (size_t)u.pm * TSTEP1K; u.b = XG + (size_t)u.pn * TSTEP1K; return true; }
        L -= 256; if (L >= 24) return false;
        const int tile = (int)L;
        if (tile < 20) { u.pm = 128 + (tile & 1); u.pn = tile >> 1; u.kind = 0; u.a = XG + (size_t)u.pm * TSTEP1K; u.b = Wmain + (size_t)u.pn * TSTEP1K; }
        else { const int tt = tile - 20; u.pm = tt & 1; u.pn = 128 + (tt >> 1); u.kind = 1; u.a = Wv + (size_t)u.pm * TSTEP1K; u.b = XG + (size_t)u.pn * TSTEP1K; }
        return true;
    }
};

struct SchedUp {
    const char* A; const char* Bt; int G, c, cbase;
    __device__ __forceinline__ bool next(int i, Unit& u) const {
        long L = (long)i * G + c;
        u.kind = 0; u.nt = 16; u.slice = 0; u.nsplit = 1; u.tile = 0;
        if (L < 130 * 22) { pg8::map_tile((int)L, 130, 22, u.pm, u.pn); u.pad = 254 * u.pm - 2; }
        else { L -= 130 * 22; if (L >= 44) return false; u.pm = 130 + (int)(L & 1); u.pn = (int)(L >> 1); u.pad = NP + 256 * (int)(L & 1); }
        u.a = A + (ptrdiff_t)u.pad * 2048; u.b = Bt + (size_t)u.pn * TSTEP1K; return true;
    }
};

struct EpiIn {
    static constexpr bool PERM = true, AFTER_DRAIN = false;
    int l;
    __device__ __forceinline__ void pre_issue(const Unit& u, int ui, int wid, int lane, LAS unsigned char* lds) const {
        pre_rows((const float*)((unsigned char*)karg(20) + WS_SSQ), 256 * (u.kind == 0 ? u.pm : u.pn), ui, wid, lane, lds);
    }
    __device__ __forceinline__ void operator()(f32x4 (&acc)[2][2][4][2], const Unit& u, int ui, int wr, int wc, int fr, int fq, int lane, LAS unsigned char* lds) const {
        asm volatile("" : "+v"(fr), "+v"(fq), "+v"(lane));
        unsigned char* wsb = (unsigned char*)karg(20); float* outb = (float*)karg(19);
        const LAS f32x4* pre = (const LAS f32x4*)(lds + EXTRA_OFF + X_PRE) + (ui & 1) * 256; bf16_t* P5 = (bf16_t*)(wsb + WS_P5); bf16_t* VT = (bf16_t*)(wsb + WS_VT); bf16_t* KF = (bf16_t*)(wsb + WS_KF);
        float* okp = outb + O_KP + (size_t)l * NB * 512 * 512; float* ovp = outb + O_VP + (size_t)l * NB * 512 * 512;
        float* oks = outb + O_KS + (size_t)l * SB * SS * 512; float* ovs = outb + O_VS + (size_t)l * SB * SS * 512;
        asm volatile("s_waitcnt lgkmcnt(0)" ::: "memory"); __builtin_amdgcn_s_barrier(); asm volatile("" ::: "memory");
        if (u.kind == 0) {
            const int rbase = u.pm * 256 + wr * 64;
            const float st0 = rstd_of(pre[64 * wr + lane]), st1 = rstd_of(pre[128 + 64 * wr + lane]);
            const bool samp = u.pm >= 128;
            const bool kout = (u.pn == 2 || u.pn == 3) && (samp || (u.pm & 7) >= 6);
#pragma unroll
            for (int ai = 0; ai < 2; ++ai)
#pragma unroll
                for (int m = 0; m < 4; ++m) {
                    const float rs = __shfl(ai ? st1 : st0, 16 * m + fr);
                    const int row = rbase + 128 * ai + 16 * m + fr;
                    if (u.pn >= 6) {
                        const f32x4 p0 = (acc[ai][0][m][0] * rs) * (acc[ai][1][m][0] * rs), p1 = (acc[ai][0][m][1] * rs) * (acc[ai][1][m][1] * rs);
                        u32x4 w; w.x = cvt_pk_bf16(p0[0], p0[1]); w.y = cvt_pk_bf16(p0[2], p0[3]); w.z = cvt_pk_bf16(p1[0], p1[1]); w.w = cvt_pk_bf16(p1[2], p1[3]);
                        *(u32x4*)(P5 + (unsigned)(row * PW + 1536 + (u.pn - 6) * 128 + wc * 32 + 8 * fq)) = w;
                    } else
#pragma unroll
                    for (int bj = 0; bj < 2; ++bj) {
                        const f32x4 v0 = acc[ai][bj][m][0] * rs, v1 = acc[ai][bj][m][1] * rs;
                        const int col0 = u.pn * 256 + bj * 128 + wc * 32 + 8 * fq;
                        u32x4 w; w.x = cvt_pk_bf16(v0[0], v0[1]); w.y = cvt_pk_bf16(v0[2], v0[3]); w.z = cvt_pk_bf16(v1[0], v1[1]); w.w = cvt_pk_bf16(v1[2], v1[3]);
                        if (u.pn == 2 || u.pn == 3) {
                            const unsigned c = (unsigned)(col0 - 512), hh = c >> 6, d0 = c & 63;
                            *(u32x4*)(KF + (unsigned)((((((unsigned)row >> 5) * 8 + hh) * 4 + (d0 >> 4)) * 32 + ((unsigned)row & 31)) * 16 + (d0 & 15))) = w;
                        } else
                        *(u32x4*)(P5 + (unsigned)(row * PW + col0)) = w;
                        if (kout) {
                            const unsigned ridx = samp ? (unsigned)(row - NP) : (unsigned)((u.pm >> 3) * 512 + (row & 2047) - 1536);
                            float* o = (samp ? oks : okp) + (unsigned)(ridx * 512 + (col0 - 512));
                            *(f32x4*)o = v0; *(f32x4*)(o + 4) = v1;
                        }
                    }
                    __builtin_amdgcn_sched_barrier(0);
                }
        } else {
            const int tok0 = u.pn * 256 + wc * 32;
            const float st = rstd_of(pre[32 * wc + 128 * (lane >> 5) + (lane & 31)]);
            float cs[2][2][4];
#pragma unroll
            for (int bj = 0; bj < 2; ++bj)
#pragma unroll
                for (int n = 0; n < 2; ++n)
#pragma unroll
                    for (int j = 0; j < 4; ++j) cs[bj][n][j] = __shfl(st, 32 * bj + 8 * fq + 4 * n + j);
            const bool samp = u.pn >= 128; const bool vout = samp || (u.pn & 7) >= 6;
#pragma unroll
            for (int ai = 0; ai < 2; ++ai)
#pragma unroll
                for (int m = 0; m < 4; ++m) {
                    const int ch = u.pm * 256 + 128 * ai + 64 * wr + 16 * m + fr;
#pragma unroll
                    for (int bj = 0; bj < 2; ++bj) {
                        f32x4 v0 = acc[ai][bj][m][0], v1 = acc[ai][bj][m][1];
#pragma unroll
                        for (int j = 0; j < 4; ++j) { v0[j] *= cs[bj][0][j]; v1[j] *= cs[bj][1][j]; }
                        const int tokc = u.pn * 256 + bj * 128 + wc * 32 + 8 * fq;
                        { u32x2 w0, w1; w0.x = cvt_pk_bf16(v0[0], v0[1]); w0.y = cvt_pk_bf16(v0[2], v0[3]); w1.x = cvt_pk_bf16(v1[0], v1[1]); w1.y = cvt_pk_bf16(v1[2], v1[3]);
                          const unsigned vb = (((unsigned)tokc >> 4) * 512 + (unsigned)ch) * 16 + 4 * (((unsigned)tokc >> 3) & 1);
                          *(u32x2*)(VT + vb) = w0; *(u32x2*)(VT + vb + 8) = w1; }
                        if (vout) {
                            const unsigned ridx = samp ? (unsigned)(tokc - NP) : (unsigned)((u.pn >> 3) * 512 + (tokc & 2047) - 1536);
                            float* ob = samp ? ovs : ovp; const unsigned oi = ridx * 512 + ch;
#pragma unroll
                            for (int j = 0; j < 4; ++j) { ob[oi + j * 512] = v0[j]; ob[oi + (4 + j) * 512] = v1[j]; }
                        }
                    }
                    __builtin_amdgcn_sched_barrier(0);
                }
        }
    }
};

struct EpiRes {
    static constexpr bool PERM = true, AFTER_DRAIN = false;
    bf16_t* XG; float* ssq4;
    __device__ __forceinline__ void pre_issue(const Unit&, int, int, int, LAS unsigned char*) const {}
    __device__ __forceinline__ void operator()(f32x4 (&acc)[2][2][4][2], const Unit& u, int ui, int wr, int wc, int fr, int fq, int lane, LAS unsigned char* lds) const {
        asm volatile("" : "+v"(fr), "+v"(fq), "+v"(lane));
        const unsigned cbase = (unsigned)(u.pn * 256 + wc * 32 + 8 * fq), rb = (unsigned)(u.pm * 256 + 64 * wr + fr);
        LAS float* red = (LAS float*)(lds + EXTRA_OFF);
        u32x4 xin[2][2];
#define EPR_LOAD(IT, BUF) do { const unsigned row_ = rb + 128 * ((IT) >> 2) + 16 * ((IT) & 3); _Pragma("unroll") for (int bj = 0; bj < 2; ++bj) \
            xin[BUF][bj] = *(const u32x4*)(XG + (row_ * DM + cbase + bj * 128)); } while (0)
        EPR_LOAD(0, 0);
#pragma unroll
        for (int it = 0; it < 8; ++it) {
            if (it + 1 < 8) EPR_LOAD(it + 1, (it + 1) & 1);
            __builtin_amdgcn_sched_barrier(0);
            const int ai = it >> 2, m = it & 3;
            const unsigned row = rb + 128 * ai + 16 * m;
            float ss = 0.f;
#pragma unroll
            for (int bj = 0; bj < 2; ++bj) {
                const u32x4 xw = xin[it & 1][bj];
                f32x4 v0, v1;
                v0[0] = __builtin_bit_cast(float, xw.x << 16); v0[1] = __builtin_bit_cast(float, xw.x & 0xffff0000u); v0[2] = __builtin_bit_cast(float, xw.y << 16); v0[3] = __builtin_bit_cast(float, xw.y & 0xffff0000u);
                v1[0] = __builtin_bit_cast(float, xw.z << 16); v1[1] = __builtin_bit_cast(float, xw.z & 0xffff0000u); v1[2] = __builtin_bit_cast(float, xw.w << 16); v1[3] = __builtin_bit_cast(float, xw.w & 0xffff0000u);
                v0 += acc[ai][bj][m][0]; v1 += acc[ai][bj][m][1];
                ss += ((v0[0] * v0[0] + v0[1] * v0[1]) + (v0[2] * v0[2] + v0[3] * v0[3])) + ((v1[0] * v1[0] + v1[1] * v1[1]) + (v1[2] * v1[2] + v1[3] * v1[3]));
                u32x4 w; w.x = cvt_pk_bf16(v0[0], v0[1]); w.y = cvt_pk_bf16(v0[2], v0[3]); w.z = cvt_pk_bf16(v1[0], v1[1]); w.w = cvt_pk_bf16(v1[2], v1[3]);
                *(u32x4*)(XG + (row * DM + cbase + bj * 128)) = w;
            }
            ss += __shfl_xor(ss, 16); ss += __shfl_xor(ss, 32);
            if (fq == 0) red[(128 * ai + 64 * wr + 16 * m + fr) * 4 + wc] = ss;
            __builtin_amdgcn_sched_barrier(0);
        }
#undef EPR_LOAD
        asm volatile("s_waitcnt lgkmcnt(0)" ::: "memory"); __builtin_amdgcn_s_barrier(); asm volatile("" ::: "memory");
        { const int t_ = (wr * 4 + wc) * 64 + lane; if (t_ < 256) { const f32x4 p = *(const LAS f32x4*)(red + 4 * t_); ssq4[(unsigned)((u.pm * 256 + t_) * 4 + u.pn)] = (p.x + p.y) + (p.z + p.w); } }
    }
};

struct EpiUp {
    static constexpr bool PERM = true, AFTER_DRAIN = false;
    int l;
    __device__ __forceinline__ void pre_issue(const Unit& u, int ui, int wid, int lane, LAS unsigned char* lds) const {
        pre_rows((const float*)((unsigned char*)karg(20) + WS_SSQ) + (1u << 18), u.pad, ui, wid, lane, lds);
        const int arr = wid >> 1, hf = wid & 1;
        const float* src = (arr < 3 ? karg(15) + (size_t)l * 3 * UPW + (size_t)arr * UPW : karg(16) + (size_t)l * UPW) + hf * DFF + u.pn * 128 + lane;
        LAS unsigned* wd = (LAS unsigned*)(lds + EXTRA_OFF + X_W) + (ui & 1) * 1024 + arr * 256 + hf * 128;
        __builtin_amdgcn_global_load_lds((const unsigned*)src, wd, 4, 0, 0);
        __builtin_amdgcn_global_load_lds((const unsigned*)(src + 64), wd + 64, 4, 0, 0);
    }
    __device__ __forceinline__ void operator()(f32x4 (&acc)[2][2][4][2], const Unit& u, int ui, int wr, int wc, int fr, int fq, int lane, LAS unsigned char* lds) const {
        asm volatile("" : "+v"(fr), "+v"(fq), "+v"(lane));
        unsigned char* wsb = (unsigned char*)karg(20); float* outb = (float*)karg(19);
        const LAS f32x4* pre = (const LAS f32x4*)(lds + EXTRA_OFF + X_PRE) + (ui & 1) * 256; (void)wsb;
        float* offs = outb + O_FS + (size_t)l * SB * 2 * UPW;
        const int rbase = u.pad + wr * 64;
        const bool samp = u.pm >= 130;
        asm volatile("s_waitcnt lgkmcnt(0)" ::: "memory"); __builtin_amdgcn_s_barrier(); asm volatile("" ::: "memory");
        const float st0 = rstd_of(pre[64 * wr + lane]), st1 = rstd_of(pre[128 + 64 * wr + lane]);
        LAS float* halo = (LAS float*)(lds + EXTRA_OFF);
        const int ccol = wc * 32 + 8 * fq;
#pragma unroll
        for (int ai = 0; ai < 2; ++ai)
#pragma unroll
            for (int m = 0; m < 4; ++m) {
                const float rs = __shfl(ai ? st1 : st0, 16 * m + fr);
#pragma unroll
                for (int bj = 0; bj < 2; ++bj)
#pragma unroll
                    for (int n = 0; n < 2; ++n) acc[ai][bj][m][n] *= rs;
            }
        if (fr >= 14) {
#pragma unroll
            for (int ai = 0; ai < 2; ++ai)
#pragma unroll
                for (int bj = 0; bj < 2; ++bj)
#pragma unroll
                    for (int n = 0; n < 2; ++n) *(LAS f32x4*)(halo + ((2 * ai + wr) * 2 + (fr - 14)) * 256 + bj * 128 + ccol + 4 * n) = acc[ai][bj][3][n];
        }
        if (!samp) {
        } else if (fr >= 14) {
#pragma unroll
            for (int ai = 0; ai < 2; ++ai)
#pragma unroll
                for (int m = 0; m < 4; ++m) {
                    const int s = (rbase + 128 * ai + 16 * m - NP) >> 4;
#pragma unroll
                    for (int bj = 0; bj < 2; ++bj)
#pragma unroll
                        for (int n = 0; n < 2; ++n) *(f32x4*)(offs + (unsigned)((s * 2 + (fr - 14)) * UPW + bj * DFF + u.pn * 128 + ccol + 4 * n)) = acc[ai][bj][m][n];
                }
        }
        asm volatile("s_waitcnt lgkmcnt(0)" ::: "memory"); __builtin_amdgcn_s_barrier(); asm volatile("" ::: "memory");
        const LAS float* wl_ = (const LAS float*)(lds + EXTRA_OFF + X_W) + (ui & 1) * 1024;
        const int lo2 = u.pad + 2, mb = ((lo2 + 2044) >> 11) << 11; const bool bnd = mb <= lo2 + 255;
        if (samp) conv_act<true, false>(acc, u, wr, fr, rbase, ccol, halo, wl_); else if (bnd) conv_act<false, true>(acc, u, wr, fr, rbase, ccol, halo, wl_); else conv_act<false, false>(acc, u, wr, fr, rbase, ccol, halo, wl_);
    }
    template <bool SAMP, bool BND>
    __device__ __forceinline__ void conv_act(const f32x4 (&acc)[2][2][4][2], const Unit& u, int wr, int fr, int rbase, int ccol, LAS float* halo, const LAS float* wl_) const {
        unsigned char* wsb = (unsigned char*)karg(20);
        bf16_t* ACT = (bf16_t*)(wsb + WS_ACT); const float* sffn = karg(5) + (size_t)l * SB * 2 * UPW; float* offp = (float*)karg(19) + O_FP + (size_t)l * NB * 2 * UPW;
        u32x2 keep[2][4];
#pragma unroll
        for (int n = 0; n < 2; ++n) {
            f32x4 W0[2], W1[2], W2[2], BB[2];
#pragma unroll
            for (int bj = 0; bj < 2; ++bj) {
                const int tc = bj * 128 + ccol + 4 * n;
                W0[bj] = *(const LAS f32x4*)(wl_ + tc); W1[bj] = *(const LAS f32x4*)(wl_ + 256 + tc); W2[bj] = *(const LAS f32x4*)(wl_ + 512 + tc); BB[bj] = *(const LAS f32x4*)(wl_ + 768 + tc);
            }
#pragma unroll
            for (int ai = 0; ai < 2; ++ai)
#pragma unroll
                for (int m = 0; m < 4; ++m) {
                    const int row = rbase + 128 * ai + 16 * m + fr;
                    const bool ok = SAMP || (row < NP && !(ai == 0 && m == 0 && wr == 0 && fr < 2));
                    const int t4 = (row + 2) & 2047;
                    const float z1 = (BND && t4 == 2) ? 0.f : 1.f, z2 = (BND && (t4 == 2 || t4 == 3)) ? 0.f : 1.f;
                    f32x4 a[2];
#pragma unroll
                    for (int bj = 0; bj < 2; ++bj) {
                        f32x4 prev;
                        if (SAMP) { const int s = (rbase + 128 * ai + 16 * m - NP) >> 4; prev = *(const f32x4*)(sffn + (unsigned)((s * 2 + (fr & 1)) * UPW + bj * DFF + u.pn * 128 + ccol + 4 * n)); }
                        else if (m > 0) prev = acc[ai][bj][m > 0 ? m - 1 : 0][n];
                        else { const int blk = 2 * ai + wr; prev = (f32x4){0.f, 0.f, 0.f, 0.f}; if (blk > 0) prev = *(const LAS f32x4*)(halo + ((blk - 1) * 2 + (fr & 1)) * 256 + bj * 128 + ccol + 4 * n); }
                        const f32x4 cur = acc[ai][bj][m][n];
#pragma unroll
                        for (int j = 0; j < 4; ++j) {
                            const float p1 = dppf<0x111>(dppf<0x121>(0.f, prev[j]), cur[j]);
                            const float p2 = dppf<0x112>(dppf<0x122>(0.f, prev[j]), cur[j]);
                            a[bj][j] = BB[bj][j] + W2[bj][j] * cur[j] + W1[bj][j] * (BND ? p1 * z1 : p1) + W0[bj][j] * (BND ? p2 * z2 : p2);
                        }
                        if (BND) { if (ok && t4 < 2 && row >= 2046) *(f32x4*)(offp + (unsigned)(((((row + 2) >> 11) - 1) * 2 + t4) * UPW + bj * DFF + u.pn * 128 + ccol + 4 * n)) = cur; }
                        __builtin_amdgcn_sched_barrier(0);
                    }
                    float o[4];
#pragma unroll
                    for (int j = 0; j < 4; ++j) { const float g = a[0][j], v = a[1][j]; o[j] = g * __builtin_amdgcn_rcpf(1.0f + __builtin_amdgcn_exp2f(-g * LOG2E)) * v; }
                    u32x2 w; w.x = cvt_pk_bf16(o[0], o[1]); w.y = cvt_pk_bf16(o[2], o[3]);
                    if (n == 0) keep[ai][m] = w;
                    else if (ok) { u32x4 w4; w4.x = keep[ai][m].x; w4.y = keep[ai][m].y; w4.z = w.x; w4.w = w.y; *(u32x4*)(ACT + (unsigned)(row * DFF + u.pn * 128 + ccol)) = w4; }
                    __builtin_amdgcn_sched_barrier(0);
                }
        }
    }
};
template <int NQB>
__device__ __forceinline__ void attn_wave(const bf16_t* qp, const bf16_t* kpast, const bf16_t* vpast, int Tpast, const bf16_t* kcur, const bf16_t* vcur, int Tcur, int hd,
                                          int t0, int nvalid_cur, int nq, const LAS float* tbl, bf16_t* outp, const float* gvec, int lane, LAS bf16x8* qlds) {
    const int r = lane & 31, h = lane >> 5;
    constexpr float SC = 0.125f * LOG2E;
#pragma unroll
    for (int qb = 0; qb < NQB; ++qb)
#pragma unroll
        for (int ks = 0; ks < 4; ++ks) qlds[(qb * 4 + ks) * 64 + lane] = *(const bf16x8*)(qp + (size_t)(32 * qb + r) * PW + 16 * ks + 8 * h);
    f32x16 o[2][NQB]; float mrun[NQB], lrun[NQB];
#pragma unroll
    for (int qb = 0; qb < NQB; ++qb) { mrun[qb] = -1e30f; lrun[qb] = 0.f;
#pragma unroll
        for (int db = 0; db < 2; ++db)
#pragma unroll
            for (int i = 0; i < 16; ++i) o[db][qb][i] = 0.f; }
    const float bconst = tbl[191];
    const unsigned vlane = (unsigned)(r * 16 + 8 * h);
    bf16x8 kf[2][4];
#define ATTN_KLOAD(TT) do { const bf16_t* kb_ = (TT) < 8 ? kpast : kcur; const unsigned T0_ = (unsigned)((TT) < 8 ? Tpast + 64 * (TT) : Tcur); \
        _Pragma("unroll") for (int kb = 0; kb < 2; ++kb) { const unsigned T_ = T0_ + 32 * kb + r; const unsigned ko_ = ((T_ >> 5) * 32 + hd * 4) * 512 + (T_ & 31) * 16 + 8 * h; \
            _Pragma("unroll") for (int ks = 0; ks < 4; ++ks) kf[kb][ks] = *(const bf16x8*)(kb_ + ko_ + ks * 512); } } while (0)
    ATTN_KLOAD(t0);
    for (int t = t0; t <= 8; ++t) {
        const bf16_t* vp = t < 8 ? vpast : vcur; const unsigned Tv = (unsigned)(t < 8 ? Tpast + 64 * t : Tcur);
        bf16x8 vf[2][2][2];
#pragma unroll
        for (int kb = 0; kb < 2; ++kb)
#pragma unroll
            for (int sx = 0; sx < 2; ++sx)
#pragma unroll
                for (int db = 0; db < 2; ++db)
                    vf[kb][sx][db] = *(const bf16x8*)(vp + (size_t)(((Tv >> 4) + 2 * kb + sx) * 512 + hd * 64 + 32 * db) * 16 + vlane);
        __builtin_amdgcn_sched_barrier(0);
        const int koff = -512 + 64 * t;
#pragma unroll
        for (int qb = 0; qb < NQB; ++qb) {
            f32x16 s[2];
#pragma unroll
            for (int kb = 0; kb < 2; ++kb)
#pragma unroll
                for (int i = 0; i < 16; ++i) s[kb][i] = 0.f;
#pragma unroll
            for (int ks = 0; ks < 4; ++ks) {
                const bf16x8 qf = qlds[(qb * 4 + ks) * 64 + lane];
                s[0] = __builtin_amdgcn_mfma_f32_32x32x16_bf16(kf[0][ks], qf, s[0], 0, 0, 0);
                s[1] = __builtin_amdgcn_mfma_f32_32x32x16_bf16(kf[1][ks], qf, s[1], 0, 0, 0);
            }
            __builtin_amdgcn_sched_barrier(0);
            if (qb == NQB - 1 && t < 8) {
                ATTN_KLOAD(t + 1);
                __builtin_amdgcn_sched_barrier(0);
            }
            float mx = mrun[qb];
            if (t <= 5) {
#pragma unroll
                for (int kb = 0; kb < 2; ++kb)
#pragma unroll
                    for (int i = 0; i < 16; ++i) { const float v = s[kb][i] * SC + bconst; s[kb][i] = v; mx = fmaxf(mx, v); }
            } else {
                const LAS float* tl = tbl + (32 * qb + r - koff - 4 * h);
#pragma unroll
                for (int kb = 0; kb < 2; ++kb)
#pragma unroll
                    for (int i = 0; i < 16; ++i) {
                        const int kin = 32 * kb + (i & 3) + 8 * (i >> 2);
                        float v = s[kb][i] * SC + tl[63 - kin];
                        if (t == 8 && (kin + 4 * h) >= nvalid_cur) v = -1e30f;
                        s[kb][i] = v; mx = fmaxf(mx, v);
                    }
            }
            mx = fmaxf(mx, __shfl_xor(mx, 32));
            const float alpha = __builtin_amdgcn_exp2f(mrun[qb] - mx); mrun[qb] = mx;
            float ps = 0.f;
#pragma unroll
            for (int kb = 0; kb < 2; ++kb)
#pragma unroll
                for (int i = 0; i < 16; ++i) { const float p = __builtin_amdgcn_exp2f(s[kb][i] - mx); s[kb][i] = p; ps += p; }
            lrun[qb] = lrun[qb] * alpha + ps;
#pragma unroll
            for (int db = 0; db < 2; ++db)
#pragma unroll
                for (int i = 0; i < 16; ++i) o[db][qb][i] *= alpha;
#pragma unroll
            for (int kb = 0; kb < 2; ++kb)
#pragma unroll
                for (int sx = 0; sx < 2; ++sx) {
                    u32x4 w; const f32x16& sv = s[kb];
                    w.x = cvt_pk_bf16(sv[8 * sx + 0], sv[8 * sx + 1]); w.y = cvt_pk_bf16(sv[8 * sx + 2], sv[8 * sx + 3]);
                    w.z = cvt_pk_bf16(sv[8 * sx + 4], sv[8 * sx + 5]); w.w = cvt_pk_bf16(sv[8 * sx + 6], sv[8 * sx + 7]);
                    const bf16x8 pf = __builtin_bit_cast(bf16x8, w);
#pragma unroll
                    for (int db = 0; db < 2; ++db) o[db][qb] = __builtin_amdgcn_mfma_f32_32x32x16_bf16(vf[kb][sx][db], pf, o[db][qb], 0, 0, 0);
                }
            __builtin_amdgcn_sched_barrier(0);
        }
    }
    int lane2 = lane; asm volatile("" : "+v"(lane2));
    const int r2 = lane2 & 31, h2 = lane2 >> 5;
#pragma unroll
    for (int qb = 0; qb < NQB; ++qb) {
        float l = lrun[qb]; l += __shfl_xor(l, 32);
        const float inv = 1.0f / l; float ss = 0.f;
#pragma unroll
        for (int db = 0; db < 2; ++db)
#pragma unroll
            for (int i = 0; i < 16; ++i) { const float v = o[db][qb][i] * inv; o[db][qb][i] = v; ss += v * v; }
        ss += __shfl_xor(ss, 32);
        const float rn = rsqrtf(ss * (1.0f / 64.0f) + EPS);
        const int q = 32 * qb + r2;
#pragma unroll
        for (int db = 0; db < 2; ++db) {
            u32x2 pk[4];
#pragma unroll
            for (int g4 = 0; g4 < 4; ++g4) {
                pk[g4].x = cvt_pk_bf16(o[db][qb][4 * g4 + 0] * rn, o[db][qb][4 * g4 + 1] * rn);
                pk[g4].y = cvt_pk_bf16(o[db][qb][4 * g4 + 2] * rn, o[db][qb][4 * g4 + 3] * rn);
            }
#pragma unroll
            for (int k = 0; k < 2; ++k) {
                const u32x2 lo = pk[2 * k], hi = pk[2 * k + 1];
                const u32x2 snd = h2 ? lo : hi;
                u32x2 rcv; rcv.x = (unsigned)__shfl_xor((int)snd.x, 32); rcv.y = (unsigned)__shfl_xor((int)snd.y, 32);
                u32x4 w;
                if (h2) { w.x = rcv.x; w.y = rcv.y; w.z = hi.x; w.w = hi.y; } else { w.x = lo.x; w.y = lo.y; w.z = rcv.x; w.w = rcv.y; }
                if (q < nq) *(u32x4*)(outp + (unsigned)(q * DM + 32 * db + 16 * k + 8 * h2)) = w;
            }
        }
    }
}

__device__ __forceinline__ void unp8(const u32x4 w, float (&v)[8]) {
    v[0] = __builtin_bit_cast(float, w.x << 16); v[1] = __builtin_bit_cast(float, w.x & 0xffff0000u);
    v[2] = __builtin_bit_cast(float, w.y << 16); v[3] = __builtin_bit_cast(float, w.y & 0xffff0000u);
    v[4] = __builtin_bit_cast(float, w.z << 16); v[5] = __builtin_bit_cast(float, w.z & 0xffff0000u);
    v[6] = __builtin_bit_cast(float, w.w << 16); v[7] = __builtin_bit_cast(float, w.w & 0xffff0000u);
}
__device__ __forceinline__ void ld8(const bf16_t* p, float (&v)[8]) {
    const u32x4 w = *(const u32x4*)p;
    v[0] = __builtin_bit_cast(float, w.x << 16); v[1] = __builtin_bit_cast(float, w.x & 0xffff0000u);
    v[2] = __builtin_bit_cast(float, w.y << 16); v[3] = __builtin_bit_cast(float, w.y & 0xffff0000u);
    v[4] = __builtin_bit_cast(float, w.z << 16); v[5] = __builtin_bit_cast(float, w.z & 0xffff0000u);
    v[6] = __builtin_bit_cast(float, w.w << 16); v[7] = __builtin_bit_cast(float, w.w & 0xffff0000u);
}
__device__ __forceinline__ void conv_run(int run, const bf16_t* P5, bf16_t* MIX, const float* cw, const float* cg_, const float* smix, float* ocp, float* ocs, int lane) {
    const int R0 = run * 16, c0 = 8 * lane;
    float w0[8], w1[8], w2[8], gg[8], h0[8], h1[8];
#pragma unroll
    for (int j = 0; j < 8; ++j) { w0[j] = cw[c0 + j]; w1[j] = cw[512 + c0 + j]; w2[j] = cw[1024 + c0 + j]; gg[j] = cg_[c0 + j]; }
    const bool samp = R0 >= NP;
    if (samp) { const int s = (R0 - NP) >> 4;
#pragma unroll
        for (int j = 0; j < 8; ++j) { h0[j] = smix[(size_t)(s * 2 + 0) * 512 + c0 + j]; h1[j] = smix[(size_t)(s * 2 + 1) * 512 + c0 + j]; }
    } else if ((R0 & 2047) == 0) {
#pragma unroll
        for (int j = 0; j < 8; ++j) { h0[j] = 0.f; h1[j] = 0.f; }
    } else {
        ld8(P5 + (size_t)(R0 - 2) * PW + 1536 + c0, h0);
        ld8(P5 + (size_t)(R0 - 1) * PW + 1536 + c0, h1);
    }
    for (int i0 = 0; i0 < 16; i0 += 8) {
        u32x4 rb[8], rc[8];
#pragma unroll
        for (int k = 0; k < 8; ++k) { const bf16_t* rp = P5 + (size_t)(R0 + i0 + k) * PW + c0; rb[k] = *(const u32x4*)(rp + 1024); rc[k] = *(const u32x4*)(rp + 1536); }
#pragma unroll
        for (int k = 0; k < 8; ++k) {
            float bv[8], cv[8], z[8];
            unp8(rb[k], bv); unp8(rc[k], cv);
            float ss = 0.f;
#pragma unroll
            for (int j = 0; j < 8; ++j) { const float cu = cv[j]; z[j] = bv[j] * (w0[j] * h0[j] + w1[j] * h1[j] + w2[j] * cu); ss += z[j] * z[j]; h0[j] = h1[j]; h1[j] = cu; }
            ss += __shfl_xor(ss, 1); ss += __shfl_xor(ss, 2); ss += __shfl_xor(ss, 4);
            const float rn = rsqrtf(ss * (1.0f / 64.0f) + EPS);
                u32x4 w; w.x = cvt_pk_bf16(z[0] * rn, z[1] * rn); w.y = cvt_pk_bf16(z[2] * rn, z[3] * rn);
            w.z = cvt_pk_bf16(z[4] * rn, z[5] * rn); w.w = cvt_pk_bf16(z[6] * rn, z[7] * rn);
            *(u32x4*)(MIX + (size_t)(R0 + i0 + k) * DM + 512 + c0) = w;
        }
    }
    float* op = nullptr;
    if (samp) op = ocs + (size_t)((R0 - NP) >> 4) * 1024;
    else if (((R0 + 16) & 2047) == 0) op = ocp + (size_t)(R0 >> 11) * 1024;
    if (op) {
#pragma unroll
        for (int j = 0; j < 8; ++j) { op[c0 + j] = h0[j]; op[512 + c0 + j] = h1[j]; }
    }
}

__device__ __forceinline__ unsigned f2bf(float f) { unsigned u = __builtin_bit_cast(unsigned, f); return (u + 0x7fffu + ((u >> 16) & 1u)) >> 16; }
__device__ __forceinline__ unsigned pk2(float lo, float hi) { return f2bf(lo) | (f2bf(hi) << 16); }
__device__ __forceinline__ void transpose_item(const float* W, int N, int k0, int n0, bf16_t* dst, int ldd, LAS float* scr, int lane, const float* gk = nullptr) {
#pragma unroll 8
    for (int i = 0; i < 32; ++i) { const int kk = 2 * i + (lane >> 5); scr[kk * 33 + (lane & 31)] = W[(size_t)(k0 + kk) * N + n0 + (lane & 31)] * (gk ? gk[k0 + kk] : 1.0f); }
    asm volatile("s_waitcnt lgkmcnt(0)" ::: "memory");
    const int c = lane & 7;
#pragma unroll
    for (int j = 0; j < 4; ++j) { const int n = (lane >> 3) + 8 * j; const LAS float* s = scr + (8 * c) * 33 + n;
        u32x4 o; o.x = pk2(s[0 * 33], s[1 * 33]); o.y = pk2(s[2 * 33], s[3 * 33]); o.z = pk2(s[4 * 33], s[5 * 33]); o.w = pk2(s[6 * 33], s[7 * 33]);
        *(u32x4*)(dst + (size_t)n * ldd + k0 + 8 * c) = o; }
    asm volatile("s_waitcnt lgkmcnt(0)" ::: "memory");
}

__device__ __forceinline__ void transpose_item_v(const float* W, int k0, int n0, bf16_t* dst, int Tbase, LAS float* scr, int lane) {
#pragma unroll 8
    for (int i = 0; i < 32; ++i) { const int kk = 2 * i + (lane >> 5); scr[kk * 33 + (lane & 31)] = W[(size_t)(k0 + kk) * 512 + n0 + (lane & 31)]; }
    asm volatile("s_waitcnt lgkmcnt(0)" ::: "memory");
    const int c = lane & 7;
#pragma unroll
    for (int j = 0; j < 4; ++j) { const int n = (lane >> 3) + 8 * j; const LAS float* s = scr + (8 * c) * 33 + n;
        u32x2 o0, o1; o0.x = pk2(s[0 * 33], s[1 * 33]); o0.y = pk2(s[2 * 33], s[3 * 33]); o1.x = pk2(s[4 * 33], s[5 * 33]); o1.y = pk2(s[6 * 33], s[7 * 33]);
        const unsigned T = (unsigned)(Tbase + k0 + 8 * c);
        const unsigned vb = ((T >> 4) * 512 + (unsigned)(n0 + n)) * 16 + 4 * ((T >> 3) & 1);
        *(u32x2*)(dst + vb) = o0; *(u32x2*)(dst + vb + 8) = o1; }
    asm volatile("s_waitcnt lgkmcnt(0)" ::: "memory");
}
#define XB_TMO      128
#define XB_XCNT(j)  (256  + 64 * (j))
#define XB_XSUB(j)  (1280 + 64 * (j))
#define XB_XGEN(j)  (2304 + 64 * (j))
#define XB_TOP      3328
#define XB_TOPGEN   3392
#define XCD_BAR_WORDS 3456
#define XB_SPIN_CAP (1u << 18)

__device__ __forceinline__ unsigned xb_ld(unsigned* p)              { return __hip_atomic_load(p, __ATOMIC_RELAXED, __HIP_MEMORY_SCOPE_AGENT); }
__device__ __forceinline__ unsigned xb_add(unsigned* p, unsigned v) { return __hip_atomic_fetch_add(p, v, __ATOMIC_RELAXED, __HIP_MEMORY_SCOPE_AGENT); }
__device__ __forceinline__ unsigned xb_xcc_id() { return (unsigned)__builtin_amdgcn_s_getreg((3 << 11) | 20) & 0xFu; }
#define XB_SPIN(cond, bar) do { unsigned _sp = 0; while (cond) { __builtin_amdgcn_s_sleep(1); \
    if ((++_sp & 255u) == 0u) { if (xb_ld(&(bar)[XB_TMO])) break; if (_sp > XB_SPIN_CAP) { atomicAdd(&(bar)[XB_TMO], 1u); break; } } } } while (0)

struct XcdBarrier {
    unsigned* bar; unsigned x;
    volatile LAS unsigned* st;
};

__device__ __forceinline__ XcdBarrier xcd_barrier_post(unsigned* bar, volatile LAS unsigned* st) {
    XcdBarrier b; b.bar = bar; b.x = xb_xcc_id(); b.st = st;
    if (threadIdx.x == 0) (void)xb_add(&bar[XB_XCNT(b.x)], 1u);
    return b;
}
__device__ __forceinline__ void xcd_barrier_complete(unsigned* bar, unsigned x, unsigned& nloc, unsigned& nx) {
    const unsigned G = gridDim.x * gridDim.y * gridDim.z;
    unsigned sum, cnt, mine, sp = 0u;
    for (;;) {
        sum = 0u; cnt = 0u; mine = 0u;
#pragma unroll
        for (unsigned j = 0; j < 16; ++j) { const unsigned c = xb_ld(&bar[XB_XCNT(j)]); sum += c; cnt += (c > 0u) ? 1u : 0u; mine = (j == x) ? c : mine; }
        if (sum == G) break;
        __builtin_amdgcn_s_sleep(1);
        if ((++sp & 255u) == 0u) { if (xb_ld(&bar[XB_TMO])) break; if (sp > XB_SPIN_CAP) { atomicAdd(&bar[XB_TMO], 1u); break; } }
    }
    nloc = mine > 0u ? mine : 1u; nx = cnt > 0u ? cnt : 1u;
}

__device__ __forceinline__ void xcd_barrier(const XcdBarrier& b) {
    asm volatile("s_waitcnt vmcnt(0)" ::: "memory");
    __syncthreads();
    int t_o = threadIdx.x; asm volatile("" : "+v"(t_o));
    if (t_o == 0) {
        unsigned* bar = b.bar;
        __builtin_amdgcn_s_waitcnt(0);
        unsigned nloc = b.st[0], nx = b.st[1];
        if (nloc == 0u) { xcd_barrier_complete(bar, b.x, nloc, nx); b.st[0] = nloc; b.st[1] = nx; }
        const unsigned old = xb_add(&bar[XB_XSUB(b.x)], 1u);
        const unsigned gen = old / nloc;
        if (old + 1u == (gen + 1u) * nloc) {
            __builtin_amdgcn_fence(__ATOMIC_RELEASE, "agent");
            asm volatile("s_waitcnt vmcnt(0)" ::: "memory");
            const unsigned og = xb_add(&bar[XB_TOP], 1u);
            const unsigned tg = og / nx;
            if (og + 1u == (tg + 1u) * nx) xb_add(&bar[XB_TOPGEN], 1u);
            else XB_SPIN(xb_ld(&bar[XB_TOPGEN]) == tg, bar);
            __builtin_amdgcn_fence(__ATOMIC_ACQUIRE, "agent");
            xb_add(&bar[XB_XGEN(b.x)], 1u);
            asm volatile("s_waitcnt vmcnt(0)" ::: "memory");
        } else {
            XB_SPIN(xb_ld(&bar[XB_XGEN(b.x)]) == gen, bar);
            __builtin_amdgcn_fence(__ATOMIC_ACQUIRE, "agent");
            asm volatile("s_waitcnt vmcnt(0)" ::: "memory");
        }
    }
    __syncthreads();
}

struct Args { const float* in[19]; float* out; unsigned char* ws; };

__global__ void __launch_bounds__(512, 2) fwd_mega(Args args) {
    extern __shared__ __attribute__((aligned(16))) unsigned char lds_raw[];
    LAS unsigned char* const lds0 = (LAS unsigned char*)lds_raw;
    cg::grid_group grid = cg::this_grid();
    volatile LAS unsigned* barst = (volatile LAS unsigned*)(lds0 + EXTRA_OFF + X_BAR);
    if (threadIdx.x < 2) barst[threadIdx.x] = 0u;
    __syncthreads();
    (void)xcd_barrier_post((unsigned*)((unsigned char*)karg(20) + WS_CTL + 4096), barst);
#define GRID_BARRIER() do { XcdBarrier b_; b_.bar = (unsigned*)((unsigned char*)karg(20) + WS_CTL + 4096); b_.x = xb_xcc_id(); b_.st = (volatile LAS unsigned*)(lds0 + EXTRA_OFF + X_BAR); xcd_barrier(b_); } while (0)
    const int G = gridDim.x, bx = blockIdx.x, NGW = G * 8;
#define out ((float*)karg(19))
#define x_prompt (karg(0))
#define x_sample (karg(1))
#define cache_k (karg(2))
#define cache_v (karg(3))
#define st_mix (karg(4))
#define st_ffn (karg(5))
#define ln1 (karg(6))
#define w_in (karg(7))
#define rel_table (karg(8))
#define conv_w (karg(9))
#define attn_g (karg(10))
#define conv_g (karg(11))
#define w_out (karg(12))
#define ln2 (karg(13))
#define w_up (karg(14))
#define fconv_w (karg(15))
#define fconv_b (karg(16))
#define w_down (karg(17))
#define final_norm (karg(18))
#define X out
#define ctr ((unsigned*)(ws + WS_CTL))
#define XG ((bf16_t*)(ws + WS_XG))
#define SSQ ((float*)(ws + WS_SSQ))
#define P5 ((bf16_t*)(ws + WS_P5))
#define VT ((bf16_t*)(ws + WS_VT))
#define ACT ((bf16_t*)(ws + WS_ACT))
#define MIX ((bf16_t*)(ws + WS_MIX))
#define KC ((bf16_t*)(ws + WS_KC))
#define VCT ((bf16_t*)(ws + WS_VCT))
#define FIRST ((float*)(ws + WS_FIRST))
#define LAST ((float*)(ws + WS_LAST))
#define KFB ((bf16_t*)(ws + WS_KF))
#define CACHE_CONVERT(LL, WIDX, NW) do { \
            const float* ck = cache_k + (size_t)(LL) * SB * 512 * 512; const float* cv = cache_v + (size_t)(LL) * SB * 512 * 512; \
            for (size_t i = (size_t)((WIDX) * 512 + tid) * 4; i < (size_t)SB * 512 * 512; i += (size_t)(NW) * 512 * 4) { \
                const f32x4 v = *(const f32x4*)(ck + i); u32x2 w; w.x = cvt_pk_bf16(v[0], v[1]); w.y = cvt_pk_bf16(v[2], v[3]); \
                const unsigned T_ = (unsigned)(i >> 9), c_ = (unsigned)(i & 511), hh_ = c_ >> 6, d_ = c_ & 63; \
                *(u32x2*)(KC + (((((T_ >> 5) * 8 + hh_) * 4 + (d_ >> 4)) * 32 + (T_ & 31)) * 16 + (d_ & 15))) = w; } \
            for (int it = (WIDX) * 8 + wave; it < SB * 128; it += (NW) * 8) { const int s_ = it >> 7, r_ = it & 127, kb_ = r_ >> 4, nb_ = r_ & 15; \
                transpose_item_v(cv + (size_t)s_ * 512 * 512, 64 * kb_, 32 * nb_, VCT, s_ * 512, scr, lane); } \
        } while (0)
#define PHASE_BEGIN int tid = threadIdx.x; asm volatile("" : "+v"(tid)); const int lane = tid & 63; const int wave = __builtin_amdgcn_readfirstlane(tid >> 6); int bxp = blockIdx.x; asm volatile("" : "+s"(bxp)); (void)bxp; const int gw = bx * 8 + wave; \
    unsigned char* ws = (unsigned char*)karg(20); unsigned ldsv = (unsigned)(size_t)lds0; asm volatile("" : "+s"(ldsv)); LAS unsigned char* lds = (LAS unsigned char*)(size_t)ldsv; LAS float* scr = (LAS float*)(lds + wave * 16384); (void)lane; (void)gw; (void)scr;

#if PH & 1
    {   PHASE_BEGIN
    if (bx == 0 && tid < 16) ctr[tid] = 0u;
        constexpr int I_IN = 16 * 96, I_OUT = 16 * 32, I_UP = 16 * 176, I_DN = 44 * 32, I_L = I_IN + I_OUT + I_UP + I_DN;
        for (int it = gw; it < DEPTH * I_L; it += NGW) {
            const int l = it / I_L; int r = it % I_L; unsigned char* wl = ws + WS_W + (size_t)l * W_LAYER;
            if (r < I_IN) { const int kb = r / 96, nb = r % 96, n0 = 32 * nb; const int drow = n0 < 1024 ? n0 : (n0 < 1536 ? 2560 + n0 - 1024 : (n0 < 2048 ? n0 - 512 : (n0 < 2560 ? 1536 + ((n0 - 2048) >> 7) * 256 + ((n0 - 2048) & 127) : 1536 + ((n0 - 2560) >> 7) * 256 + 128 + ((n0 - 2560) & 127))));
                transpose_item(w_in + (size_t)l * DM * PROJ, PROJ, 64 * kb, n0, (bf16_t*)(wl + W_IN) + (size_t)drow * 1024, 1024, scr, lane, ln1 + (size_t)l * DM); continue; }
            r -= I_IN;
            if (r < I_OUT) { const int kb = r / 32, nb = r % 32, n0 = 32 * nb;
                transpose_item(w_out + (size_t)l * DM * DM, DM, 64 * kb, n0, (bf16_t*)(wl + W_OUT) + (size_t)n0 * 1024, 1024, scr, lane, kb < 8 ? attn_g + (size_t)l * 512 : conv_g + (size_t)l * 512 - 512); continue; }
            r -= I_OUT;
            if (r < I_UP) { const int kb = r / 176, nb = r % 176, n0 = 32 * nb; const int bj = n0 / DFF, ch = n0 % DFF; const int drow = (ch >> 7) * 256 + bj * 128 + (ch & 127);
                transpose_item(w_up + (size_t)l * DM * UPW, UPW, 64 * kb, n0, (bf16_t*)(wl + W_UP) + (size_t)drow * 1024, 1024, scr, lane, ln2 + (size_t)l * DM); continue; }
            r -= I_UP;
            { const int kb = r / 32, nb = r % 32, n0 = 32 * nb;
                transpose_item(w_down + (size_t)l * DFF * DM, DM, 64 * kb, n0, (bf16_t*)(wl + W_DOWN) + (size_t)n0 * DFF, DFF, scr, lane); }
        }
        {
            for (int row0 = gw; row0 < M; row0 += 4 * NGW) {
                f32x4 xv[4][4];
#pragma unroll
                for (int k = 0; k < 4; ++k) { const int row = row0 + k * NGW; if (row < M) { const float* xr = row < NP ? x_prompt + (size_t)row * DM : x_sample + (size_t)(row - NP) * DM;
#pragma unroll
                    for (int j = 0; j < 4; ++j) xv[k][j] = *(const f32x4*)(xr + 4 * lane + 256 * j); } }
#pragma unroll
                for (int k = 0; k < 4; ++k) { const int row = row0 + k * NGW; if (row < M) {
                    float ss = 0.f;
#pragma unroll
                    for (int j = 0; j < 4; ++j) {
                        const f32x4 v = xv[k][j];
                        ss += (v[0] * v[0] + v[1] * v[1]) + (v[2] * v[2] + v[3] * v[3]);
                        u32x2 w; w.x = cvt_pk_bf16(v[0], v[1]); w.y = cvt_pk_bf16(v[2], v[3]);
                        *(u32x2*)(XG + (size_t)row * DM + 4 * lane + 256 * j) = w;
                    }
#pragma unroll
                    for (int o = 1; o < 64; o <<= 1) ss += __shfl_xor(ss, o);
                    if (lane == 0) *(f32x4*)(SSQ + (size_t)row * 4) = (f32x4){ss, 0.f, 0.f, 0.f};
                } }
            }
        }
        CACHE_CONVERT(0, bx, G);
    }
#endif
    GRID_BARRIER();
    if (gridDim.x == 0x7fffffffu) grid.sync();

    for (int l = 0; l < DEPTH; ++l) {
#define wl (ws + WS_W + (size_t)l * W_LAYER)
#if PH & 2
        {
            PHASE_BEGIN
            SchedIn S{(const char*)XG, (const char*)(wl + W_IN), (const char*)(wl + W_IN) + (size_t)2560 * 2048, G, bxp, (l * 4 + 0) * 64};
            EpiIn E{l};
            pg8::gemm_phase<EpiIn, SchedIn, true, true>(lds, 1024, S, E);
        }
#endif
        GRID_BARRIER();
#if PH & 4
        {
            PHASE_BEGIN
            LAS float* T = (LAS float*)lds;
            for (int i = tid; i < 8 * 256; i += 512) { const int hh = i >> 8, j = i & 255; int rel = j - 63; rel = rel > 128 ? 128 : rel; T[hh * 256 + j] = rel_table[(size_t)l * 8 * 257 + hh * 257 + rel + 128] * LOG2E; }
            __syncthreads();
            for (int run = gw; run < M / 16; run += NGW)
                conv_run(run, P5, MIX, conv_w + (size_t)l * 3 * 512, conv_g + (size_t)l * 512, st_mix + (size_t)l * SB * 2 * 512, out + O_CP + (size_t)l * NB * 2 * 512, out + O_CS + (size_t)l * SB * 2 * 512, lane);
            LAS int* qslot = (LAS int*)(lds + EXTRA_OFF + 8192);
            const int hd = wave;
            for (;;) {
                __syncthreads();
                if (tid == 0) *qslot = (int)atomicAdd(ctr + 16 + l * 8 + (bx & 7), 1u);
                __syncthreads();
                const int v = *qslot;
                if (v >= 68) break;
                int ln = threadIdx.x & 63; asm volatile("" : "+v"(ln));
                const int xg = bx & 7;
                int b = 0, c = 0, s = -1;
                if (v < 48) { b = 2 * xg + v / 24; c = 8 + v % 24; }
                else if (v < 56) { const int k = v - 48; c = 7 - (k >> 1); b = 2 * xg + (k & 1); }
                else if (v < 60) { s = 4 * xg + (v - 56); }
                else { const int k = v - 60; c = 3 - (k >> 1); b = 2 * xg + (k & 1); }
                {
                    const bool smp = s >= 0;
                    const int row0 = smp ? NP + s * SS : b * SEQ + c * 64;
                    attn_wave<2>(P5 + (size_t)row0 * PW + hd * 64, smp ? KC : KFB, smp ? VCT : VT, smp ? s * 512 : row0 - 512, KFB, VT, row0, hd,
                                 (smp || c >= 8) ? 0 : 8 - c, smp ? SS : 64, smp ? SS : 64,
                                 T + hd * 256, MIX + (size_t)row0 * DM + hd * 64, attn_g + (size_t)l * 512 + hd * 64, ln, (LAS bf16x8*)(lds + 16384 + wave * 8192));
                }
            }
        }
#endif
        GRID_BARRIER();
#if PH & 8
        {
            PHASE_BEGIN
            SchedGemm S{(const char*)MIX, (const char*)(wl + W_OUT), 4, G, bxp, 16, 1, (l * 4 + 1) * 64, TSTEP1K};
            EpiRes E{XG, SSQ + (1u << 18)};
            pg8::gemm_phase<EpiRes, SchedGemm, true, true>(lds, 1024, S, E);
        }
#endif
        GRID_BARRIER();
#if PH & 16
        {
            PHASE_BEGIN
            SchedUp S{(const char*)XG, (const char*)(wl + W_UP), G, bxp, 0};
            EpiUp E{l};
            pg8::gemm_phase<EpiUp, SchedUp, true, true>(lds, 1024, S, E);
        }
#endif
        GRID_BARRIER();
#if PH & 64
        {
            PHASE_BEGIN
            SchedGemm S{(const char*)ACT, (const char*)(wl + W_DOWN), 4, G, bxp, 44, 2, (l * 4 + 3) * 64, (size_t)256 * DFF * 2};
            EpiRes E{XG, SSQ};
            pg8::gemm_phase<EpiRes, SchedGemm, true, true>(lds, DFF, S, E);
            { int bxo = blockIdx.x; asm volatile("" : "+s"(bxo)); if (l + 1 < DEPTH && bxo >= 16) { CACHE_CONVERT(l + 1, bxo - 16, G - 16); } }
        }
#endif
        GRID_BARRIER();
    }
    PHASE_BEGIN
    {
        f32x4 fg[4];
#pragma unroll
        for (int j = 0; j < 4; ++j) fg[j] = *(const f32x4*)(final_norm + 4 * lane + 256 * j);
        for (int row0 = gw; row0 < M; row0 += 4 * NGW) {
            u32x2 xw[4][4]; f32x4 pp[4];
#pragma unroll
            for (int k = 0; k < 4; ++k) { const int row = row0 + k * NGW; if (row < M) { pp[k] = *(const f32x4*)(SSQ + (size_t)row * 4);
#pragma unroll
                for (int j = 0; j < 4; ++j) xw[k][j] = *(const u32x2*)(XG + (size_t)row * DM + 4 * lane + 256 * j); } }
#pragma unroll
            for (int k = 0; k < 4; ++k) { const int row = row0 + k * NGW; if (row < M) { const float rs = rstd_of(pp[k]);
#pragma unroll
                for (int j = 0; j < 4; ++j) { const u32x2 w = xw[k][j]; f32x4 v; v[0] = __builtin_bit_cast(float, w.x << 16); v[1] = __builtin_bit_cast(float, w.x & 0xffff0000u); v[2] = __builtin_bit_cast(float, w.y << 16); v[3] = __builtin_bit_cast(float, w.y & 0xffff0000u);
                    *(f32x4*)(X + (size_t)row * DM + 4 * lane + 256 * j) = v * rs * fg[j]; } } }
        }
    }
}

#undef out
#undef X
#undef ctr
#undef wl
extern "C" void kernel_launch(void* const* d_in, const int* in_sizes, int n_in, void* d_out, int out_size, void* d_ws, size_t ws_size, hipStream_t stream) {
    static int grid = 0;
    if (grid == 0) {
        if (n_in != 19 || ws_size < WS_END) { fprintf(stderr, "kernel_launch: unexpected n_in %d / ws_size %zu (need %zu)\n", n_in, ws_size, (size_t)WS_END); grid = -1; return; }
        int dev = 0, cus = 0, per_cu = 0;
        hipGetDevice(&dev); hipDeviceGetAttribute(&cus, hipDeviceAttributeMultiprocessorCount, dev);
        if (hipFuncSetAttribute((const void*)fwd_mega, hipFuncAttributeMaxDynamicSharedMemorySize, LDS_BYTES) != hipSuccess) { fprintf(stderr, "kernel_launch: hipFuncSetAttribute failed\n"); grid = -1; return; }
        if (hipOccupancyMaxActiveBlocksPerMultiprocessor(&per_cu, (const void*)fwd_mega, 512, LDS_BYTES) != hipSuccess || per_cu < 1) { fprintf(stderr, "kernel_launch: occupancy query says %d\n", per_cu); per_cu = 1; }
        (void)hipGetLastError();
        grid = cus * 1;
    }
    if (grid < 0) return;
    if (hipMemsetAsync((char*)d_ws + WS_CTL, 0, 65536, stream) != hipSuccess) { fprintf(stderr, "kernel_launch: memset failed\n"); return; }
    Args a{};
    for (int i = 0; i < 19; ++i) a.in[i] = (const float*)d_in[i];
    a.out = (float*)d_out; a.ws = (unsigned char*)d_ws;
    void* kargs[] = {&a};
    hipError_t e = hipLaunchCooperativeKernel((const void*)fwd_mega, dim3(grid), dim3(512), kargs, LDS_BYTES, stream);
    if (e != hipSuccess) fprintf(stderr, "cooperative launch failed: %s (grid %d)\n", hipGetErrorString(e), grid);
}
```

```cpp
#ifndef PH
#define PH 127
#endif
#include <hip/hip_runtime.h>
#include <hip/hip_cooperative_groups.h>
#include <cstdio>
#include <cstdint>
namespace cg = cooperative_groups;

#define LAS __attribute__((address_space(3)))
#define PG8_LAS LAS
typedef unsigned short bf16_t;
typedef short bf16x8 __attribute__((ext_vector_type(8)));
typedef float f32x4 __attribute__((ext_vector_type(4)));
typedef float f32x16 __attribute__((ext_vector_type(16)));
typedef unsigned u32x4 __attribute__((ext_vector_type(4)));
typedef unsigned u32x2 __attribute__((ext_vector_type(2)));

constexpr int DM = 1024, NB = 16, SEQ = 2048, DEPTH = 4, SB = 32, SS = 16;
constexpr int NP = NB * SEQ, NS = SB * SS, M = NP + NS, MP = 33792;
constexpr int PW = 2560, PROJ = 3072, DFF = 2816, UPW = 5632, LDV = MP;
constexpr float EPS = 1e-6f, LOG2E = 1.4426950408889634f;
constexpr size_t O_Y = 0;
constexpr size_t O_KP = (size_t)M * DM;
constexpr size_t O_VP = O_KP + (size_t)DEPTH * NB * 512 * 512;
constexpr size_t O_CP = O_VP + (size_t)DEPTH * NB * 512 * 512;
constexpr size_t O_FP = O_CP + (size_t)DEPTH * NB * 2 * 512;
constexpr size_t O_KS = O_FP + (size_t)DEPTH * NB * 2 * UPW;
constexpr size_t O_VS = O_KS + (size_t)DEPTH * SB * SS * 512;
constexpr size_t O_CS = O_VS + (size_t)DEPTH * SB * SS * 512;
constexpr size_t O_FS = O_CS + (size_t)DEPTH * SB * 2 * 512;
constexpr size_t MiB = 1u << 20;
constexpr size_t WS_CTL = 0;
constexpr size_t WS_W = 1 * MiB;
constexpr size_t W_IN = 0, W_OUT = 6 * MiB, W_UP = 8 * MiB, W_DOWN = 19 * MiB, W_LAYER = 25 * MiB;
constexpr size_t WS_XG = WS_W + 4 * W_LAYER;
constexpr size_t WS_SSQ = WS_XG + 66 * MiB;
constexpr size_t WS_P5 = WS_SSQ + 3 * MiB;
constexpr size_t WS_VT = WS_P5 + 165 * MiB;
constexpr size_t WS_ACT = WS_P5;
constexpr size_t WS_MIX = WS_VT + 33 * MiB;
constexpr size_t WS_KC = WS_MIX + 66 * MiB;
constexpr size_t WS_VCT = WS_KC + 16 * MiB;
constexpr size_t WS_FIRST = WS_VCT + 16 * MiB;
constexpr size_t WS_LAST = WS_FIRST + 6 * MiB;
constexpr size_t WS_KF = WS_LAST + 6 * MiB;
constexpr size_t WS_PART = WS_KF + 34 * MiB;
constexpr size_t WS_END = WS_PART + 22 * MiB;
static_assert((size_t)MP * 2816 * 2 <= (size_t)198 * MiB, "ACT overlay");
constexpr int LDS_BYTES = 156160, EXTRA_OFF = 131072;
constexpr int X_PRE = 8448, X_W = 16640, X_BAR = 24832;

__device__ __forceinline__ unsigned cvt_pk_bf16(float lo, float hi) { unsigned r; asm volatile("v_cvt_pk_bf16_f32 %0, %1, %2" : "=v"(r) : "v"(lo), "v"(hi)); return r; }
__device__ __forceinline__ float bf2f(unsigned short b) { return __builtin_bit_cast(float, (unsigned)b << 16); }
__device__ __forceinline__ float rstd_of(f32x4 p) { return rsqrtf(((p.x + p.y) + (p.z + p.w)) * (1.0f / 1024.0f) + EPS); }
template <int CTRL> __device__ __forceinline__ float dppf(float old, float src) {
    return __builtin_bit_cast(float, __builtin_amdgcn_update_dpp(__builtin_bit_cast(int, old), __builtin_bit_cast(int, src), CTRL, 0xf, 0xf, false));
}

typedef const __attribute__((address_space(4))) char* kargp_t;
__device__ __forceinline__ const float* karg(int k) { kargp_t p = (kargp_t)__builtin_amdgcn_kernarg_segment_ptr(); asm volatile("" : "+s"(p)); return *(const float* const __attribute__((address_space(4)))*)(p + 8 * k); }
namespace pg8 {
constexpr int BM = 256, BK = 64, HALF = 128, HTB = HALF * BK * 2, STAGE_BYTES = 8 * HTB, NXCD = 8, WGM = 6;
__host__ __device__ __forceinline__ int lds_byte(int r, int c) { const int st = (r >> 4) * 2 + (c >> 5), rr = r & 15, cc = c & 31, ob = rr * 64 + cc * 2; return st * 1024 + (ob ^ (((ob >> 9) & 1) << 5)); }
__host__ __device__ __forceinline__ void stage_rc(int b, int& R, int& C) { const int st = b / 1024, sb = b % 1024, swz = sb ^ (((sb >> 9) & 1) << 5); R = (st >> 1) * 16 + swz / 64; C = (st & 1) * 32 + (swz % 64) / 2; }
__host__ __device__ __forceinline__ int perm32(int rho) { const int n = rho >> 4, i = rho & 15; return 8 * (i >> 2) + 4 * n + (i & 3); }
struct Unit { int pm, pn, kind, nt; int slice, nsplit, tile, pad; const char* a; const char* b; };
__device__ __forceinline__ void map_tile(int L, int nM, int nN, int& pm, int& pn) {
    const int nwg = nM * nN; int wgid = L;
    { const int q = nwg / NXCD, r = nwg % NXCD, xcd = wgid % NXCD, off = wgid / NXCD; wgid = (xcd < r ? xcd * (q + 1) : r * (q + 1) + (xcd - r) * q) + off; }
    const int nig = WGM * nN, gid = wgid / nig, fm = gid * WGM, gsz = (nM - fm) < WGM ? (nM - fm) : WGM;
    pm = fm + ((wgid % nig) % gsz); pn = (wgid % nig) / gsz;
}
template <class Epi, class Sched, bool ALIGN_EPI = false, bool SP2 = false>
__device__ __forceinline__ void gemm_phase(PG8_LAS unsigned char* lds, const int Kdim, const Sched& S, const Epi& E) {
    int tid_o = threadIdx.x; asm volatile("" : "+v"(tid_o));
    const int tid = tid_o, wid = __builtin_amdgcn_readfirstlane(tid >> 6), lane = tid & 63, wr = wid >> 2, wc = wid & 3, fr = lane & 15, fq = lane >> 4;
    const int K = Kdim;
    unsigned voffA[2], voffB[2]; int aoff, boff;
#define PG8_ADDR_SETUP(t_) do { _Pragma("unroll") for (int i = 0; i < 2; ++i) { int R, C; stage_rc((t_) * 16 + i * 8192, R, C); const int Rb = Epi::PERM ? ((R & ~31) + perm32(R & 31)) : R; \
        voffA[i] = (unsigned)(R * K + C) * 2u; voffB[i] = (unsigned)(Rb * K + C) * 2u; } \
        aoff = lds_byte(wr * 64 + ((t_) & 15), (((t_) & 63) >> 4) * 8); boff = lds_byte(wc * 32 + ((t_) & 15), (((t_) & 63) >> 4) * 8); } while (0)
    PG8_ADDR_SETUP(tid);
    const size_t kstep = (size_t)(BK * 2);
    const size_t hstep = (size_t)HALF * K * 2;
    const size_t tstep = 2 * hstep;
    const unsigned ldsw = (unsigned)wid * 1024u;
#define PG8_SA(b, h) (((b) * 2 + (h)) * HTB)
#define PG8_SB(b, h) ((4 + (b) * 2 + (h)) * HTB)
#define PG8_STAGE(bufoff, gbase, voff) do { _Pragma("unroll") for (int _i = 0; _i < 2; ++_i) \
        __builtin_amdgcn_global_load_lds((const unsigned*)((const char*)(gbase) + (voff)[_i]), (PG8_LAS unsigned*)(lds + (bufoff) + ldsw + _i * 8192), 16, 0, 0); } while (0)
#define PG8_LDA(dst, b, h) do { _Pragma("unroll") for (int m = 0; m < 4; ++m) _Pragma("unroll") for (int k = 0; k < 2; ++k) dst[m][k] = *(const PG8_LAS bf16x8*)(lds + PG8_SA(b, h) + aoff + m * 2048 + k * 1024); } while (0)
#define PG8_LDB(dst, b, h) do { _Pragma("unroll") for (int n = 0; n < 2; ++n) _Pragma("unroll") for (int k = 0; k < 2; ++k) dst[n][k] = *(const PG8_LAS bf16x8*)(lds + PG8_SB(b, h) + boff + n * 2048 + k * 1024); } while (0)
#define PG8_MMA(ai, bj, At, Bt) do { __builtin_amdgcn_s_setprio(1); _Pragma("unroll") for (int m = 0; m < 4; ++m) _Pragma("unroll") for (int n = 0; n < 2; ++n) _Pragma("unroll") for (int k = 0; k < 2; ++k) \
        acc[ai][bj][m][n] = __builtin_amdgcn_mfma_f32_16x16x32_bf16(Bt[n][k], At[m][k], acc[ai][bj][m][n], 0, 0, 0); __builtin_amdgcn_s_setprio(0); } while (0)
#define PG8_WAIT_V(n) asm volatile("s_waitcnt vmcnt(" #n ")" ::: "memory")
#define PG8_WAIT_L(n) asm volatile("s_waitcnt lgkmcnt(" #n ")" ::: "memory")
#define PG8_BAR __builtin_amdgcn_s_barrier()
#define PG8_SCHED __builtin_amdgcn_sched_barrier(0)
    Unit cur, nxt; int ui = 0;
    if (!S.next(0, cur)) return;
    E.pre_issue(cur, 0, wid, lane, lds);
    f32x4 acc[2][2][4][2];
#pragma unroll
    for (int a = 0; a < 2; ++a)
#pragma unroll
        for (int b = 0; b < 2; ++b)
#pragma unroll
            for (int m = 0; m < 4; ++m)
#pragma unroll
                for (int n = 0; n < 2; ++n) acc[a][b][m][n] = (f32x4){0.f, 0.f, 0.f, 0.f};
    bf16x8 At[4][2], B0[2][2], B1[2][2];
    const char* cA = cur.a; const char* cB = cur.b;

    if constexpr (SP2) {
        PG8_STAGE(PG8_SB(0, 0), cB, voffB); PG8_STAGE(PG8_SB(0, 1), cB + hstep, voffB); PG8_STAGE(PG8_SA(0, 0), cA, voffA); PG8_STAGE(PG8_SA(0, 1), cA + hstep, voffA);
        if (wr == 1) PG8_BAR;
        PG8_WAIT_V(2); PG8_BAR;
        PG8_STAGE(PG8_SB(1, 0), cB + kstep, voffB); PG8_STAGE(PG8_SA(1, 0), cA + kstep, voffA); PG8_STAGE(PG8_SB(1, 1), cB + hstep + kstep, voffB);
        PG8_WAIT_V(6); PG8_BAR;
    } else {
        PG8_STAGE(PG8_SB(0, 0), cB, voffB); PG8_STAGE(PG8_SA(0, 0), cA, voffA); PG8_STAGE(PG8_SB(0, 1), cB + hstep, voffB); PG8_STAGE(PG8_SA(0, 1), cA + hstep, voffA);
        if (wr == 1) PG8_BAR;
        PG8_WAIT_V(4); PG8_BAR;
        PG8_STAGE(PG8_SB(1, 0), cB + kstep, voffB); PG8_STAGE(PG8_SA(1, 0), cA + kstep, voffA); PG8_STAGE(PG8_SB(1, 1), cB + hstep + kstep, voffB);
        PG8_WAIT_V(6); PG8_BAR;
    }
    for (;;) {
        const bool has_next = S.next(ui + 1, nxt);
        const char* nA = has_next ? nxt.a : cA; const char* nB = has_next ? nxt.b : cB;
        const int nt = cur.nt;
        for (int t = 0; t < nt; t += 2) {
            const bool last = (t == nt - 2);
            const char* a1 = cA + (size_t)(t + 1) * kstep;
            const char* a2 = last ? nA : cA + (size_t)(t + 2) * kstep; const char* b2 = last ? nB : cB + (size_t)(t + 2) * kstep;
            const char* a3 = a2 + kstep; const char* b3 = b2 + kstep;

            if constexpr (SP2) {
            PG8_LDB(B0, 0, 0); PG8_LDB(B1, 0, 1); PG8_SCHED; PG8_LDA(At, 0, 0); PG8_STAGE(PG8_SA(1, 1), a1 + hstep, voffA);
            PG8_WAIT_V(8); PG8_WAIT_L(0); PG8_BAR; PG8_MMA(0, 0, At, B0); PG8_MMA(0, 1, At, B1); PG8_BAR; PG8_SCHED;
            PG8_LDA(At, 0, 1); PG8_STAGE(PG8_SB(0, 0), b2, voffB); PG8_STAGE(PG8_SB(0, 1), b2 + hstep, voffB); PG8_STAGE(PG8_SA(0, 0), a2, voffA);
            PG8_WAIT_V(8); PG8_WAIT_L(0); PG8_BAR; PG8_MMA(1, 0, At, B0); PG8_MMA(1, 1, At, B1); PG8_BAR; PG8_SCHED;
            PG8_LDB(B0, 1, 0); PG8_LDB(B1, 1, 1); PG8_SCHED; PG8_LDA(At, 1, 0); PG8_STAGE(PG8_SA(0, 1), a2 + hstep, voffA);
            PG8_WAIT_V(8); PG8_WAIT_L(0); PG8_BAR; PG8_MMA(0, 0, At, B0); PG8_MMA(0, 1, At, B1); PG8_BAR; PG8_SCHED;
            PG8_LDA(At, 1, 1); PG8_STAGE(PG8_SB(1, 0), b3, voffB); PG8_STAGE(PG8_SB(1, 1), b3 + hstep, voffB); PG8_STAGE(PG8_SA(1, 0), a3, voffA);
            PG8_WAIT_V(8); PG8_WAIT_L(0); PG8_BAR; PG8_MMA(1, 0, At, B0); PG8_MMA(1, 1, At, B1); PG8_BAR; PG8_SCHED;
            } else {
            PG8_LDB(B0, 0, 0); PG8_SCHED; PG8_LDA(At, 0, 0); PG8_STAGE(PG8_SA(1, 1), a1 + hstep, voffA);
            PG8_WAIT_L(8); PG8_BAR; PG8_WAIT_L(0); PG8_MMA(0, 0, At, B0); PG8_BAR; PG8_SCHED;
            PG8_LDB(B1, 0, 1); PG8_STAGE(PG8_SB(0, 0), b2, voffB);
            PG8_BAR; PG8_WAIT_L(0); PG8_MMA(0, 1, At, B1); PG8_BAR;
            PG8_LDA(At, 0, 1); PG8_STAGE(PG8_SA(0, 0), a2, voffA);
            PG8_BAR; PG8_WAIT_L(0); PG8_MMA(1, 0, At, B0); PG8_BAR; PG8_SCHED;
            PG8_STAGE(PG8_SB(0, 1), b2 + hstep, voffB);
            PG8_WAIT_V(6); PG8_BAR; PG8_MMA(1, 1, At, B1); PG8_BAR;
            PG8_LDB(B0, 1, 0); PG8_SCHED; PG8_LDA(At, 1, 0); PG8_STAGE(PG8_SA(0, 1), a2 + hstep, voffA);
            PG8_WAIT_L(8); PG8_BAR; PG8_WAIT_L(0); PG8_MMA(0, 0, At, B0); PG8_BAR; PG8_SCHED;
            PG8_LDB(B1, 1, 1); PG8_STAGE(PG8_SB(1, 0), b3, voffB);
            PG8_BAR; PG8_WAIT_L(0); PG8_MMA(0, 1, At, B1); PG8_BAR;
            PG8_LDA(At, 1, 1); PG8_STAGE(PG8_SA(1, 0), a3, voffA);
            PG8_BAR; PG8_WAIT_L(0); PG8_MMA(1, 0, At, B0); PG8_BAR; PG8_SCHED;
            PG8_STAGE(PG8_SB(1, 1), b3 + hstep, voffB);
            PG8_WAIT_V(6); PG8_BAR; PG8_MMA(1, 1, At, B1); PG8_BAR;
            }
        }
        if constexpr (ALIGN_EPI) { if (wr == 0) PG8_BAR; }
        bool do_epi = true;
        if (cur.nsplit > 1) {
            float* part = (float*)((unsigned char*)karg(20) + WS_PART);
            unsigned* cnt = (unsigned*)((unsigned char*)karg(20) + WS_CTL + 32768) + S.cbase + cur.tile;
            f32x4* mine = (f32x4*)(part + ((size_t)cur.tile * 2 + cur.slice) * 65536) + tid;
#pragma unroll
            for (int a = 0; a < 2; ++a)
#pragma unroll
                for (int b = 0; b < 2; ++b)
#pragma unroll
                    for (int m = 0; m < 4; ++m) {
#pragma unroll
                        for (int n = 0; n < 2; ++n) { f32x4* p_ = mine + (((a * 2 + b) * 4 + m) * 2 + n) * 512; asm volatile("global_store_dwordx4 %0, %1, off sc1\n\ts_nop 1" :: "v"(p_), "v"(acc[a][b][m][n]) : "memory"); }
                        __builtin_amdgcn_sched_barrier(0);
                    }
            asm volatile("s_waitcnt vmcnt(0)" ::: "memory");
            PG8_BAR;
            LAS unsigned* flag = (LAS unsigned*)(lds + EXTRA_OFF + 8192 + 64);
            if (tid == 0) {
                const unsigned old = __hip_atomic_fetch_add(cnt, 1u, __ATOMIC_RELAXED, __HIP_MEMORY_SCOPE_AGENT);
                if (old == 1u) { __builtin_amdgcn_fence(__ATOMIC_ACQUIRE, "agent"); asm volatile("s_waitcnt vmcnt(0)" ::: "memory"); }
                *flag = old;
            }
            asm volatile("s_waitcnt lgkmcnt(0)" ::: "memory");
            PG8_BAR;
            const unsigned old = *flag;
            asm volatile("s_waitcnt lgkmcnt(0)" ::: "memory");
            PG8_BAR;
            do_epi = (old == 1u);
            if (do_epi) {
                const f32x4* oth = (const f32x4*)(part + ((size_t)cur.tile * 2 + (cur.slice ^ 1)) * 65536) + tid;
#pragma unroll
                for (int a = 0; a < 2; ++a)
#pragma unroll
                    for (int b = 0; b < 2; ++b) {
#pragma unroll
                        for (int m = 0; m < 4; ++m)
#pragma unroll
                            for (int n = 0; n < 2; ++n) acc[a][b][m][n] += oth[(((a * 2 + b) * 4 + m) * 2 + n) * 512];
                        __builtin_amdgcn_sched_barrier(0);
                    }
            }
        }
        if (do_epi) E(acc, cur, ui, wr, wc, fr, fq, lane, lds);
        if (!has_next) break;
#pragma unroll
        for (int a = 0; a < 2; ++a)
#pragma unroll
            for (int b = 0; b < 2; ++b)
#pragma unroll
                for (int m = 0; m < 4; ++m)
#pragma unroll
                    for (int n = 0; n < 2; ++n) acc[a][b][m][n] = (f32x4){0.f, 0.f, 0.f, 0.f};
        cur = nxt; cA = nA; cB = nB; ++ui;
        asm volatile("s_waitcnt lgkmcnt(0)" ::: "memory"); E.pre_issue(cur, ui, wid, lane, lds);
        { int t2 = threadIdx.x; asm volatile("" : "+v"(t2)); PG8_ADDR_SETUP(t2); }
        if constexpr (ALIGN_EPI) { if (wr == 1) PG8_BAR; }
    }
    PG8_WAIT_V(0);
    if constexpr (!ALIGN_EPI) { if (wr == 0) PG8_BAR; }
    PG8_BAR;

#undef PG8_ADDR_SETUP
#undef PG8_SA
#undef PG8_SB
#undef PG8_STAGE
#undef PG8_LDA
#undef PG8_LDB
#undef PG8_MMA
#undef PG8_WAIT_V
#undef PG8_WAIT_L
#undef PG8_BAR
#undef PG8_SCHED
}
}
using pg8::Unit;
__device__ __forceinline__ void pre_rows(const float* ssq4, int rowbase, int ui, int wid, int lane, LAS unsigned char* lds) {
    LAS unsigned* dst = (LAS unsigned*)(lds + EXTRA_OFF + X_PRE) + (ui & 1) * 1024 + wid * 128;
    const float* src = ssq4 + ((ptrdiff_t)rowbase + wid * 32) * 4 + lane;
    __builtin_amdgcn_global_load_lds((const unsigned*)src, dst, 4, 0, 0);
    __builtin_amdgcn_global_load_lds((const unsigned*)(src + 64), dst + 64, 4, 0, 0);
}
constexpr size_t TSTEP1K = (size_t)256 * 1024 * 2;
struct SchedGemm {
    const char* A; const char* Bt; int nN, G, c, nt, S, cbase; size_t tstep;
    __device__ __forceinline__ bool next(int i, Unit& u) const {
        long L = (long)i * G + c; const int npr = 128 * nN;
        u.kind = 0; u.pad = 0;
        if (L < npr) { pg8::map_tile((int)L, 128, nN, u.pm, u.pn); u.nt = nt; u.slice = 0; u.nsplit = 1; u.tile = 0; u.a = A + (size_t)u.pm * tstep; u.b = Bt + (size_t)u.pn * tstep; return true; }
        L -= npr; if (L >= 2 * nN * S) return false;
        const int tile = (int)(L / S), sl = (int)(L % S), nts = nt / S;
        u.pm = 128 + (tile & 1); u.pn = tile >> 1; u.nt = nts; u.slice = sl; u.nsplit = S; u.tile = tile;
        u.a = A + (size_t)u.pm * tstep + (size_t)sl * nts * 128; u.b = Bt + (size_t)u.pn * tstep + (size_t)sl * nts * 128; return true;
    }
};
struct SchedIn {
    const char* XG; const char* Wmain; const char* Wv; int G, c, cbase;
    __device__ __forceinline__ bool next(int i, Unit& u) const {
        long L = (long)i * G + c;
        u.pad = 0; u.nt = 16; u.slice = 0; u.nsplit = 1; u.tile = 0;
        if (L < 1280) { pg8::map_tile((int)L, 128, 10, u.pm, u.pn); u.kind = 0; u.a = XG + (size_t)u.pm * TSTEP1K; u.b = Wmain + (size_t)u.pn * TSTEP1K; return true; }
        L -= 1280;
        if (L < 256) { u.pm = (int)(L & 1); u.pn = (int)(L >> 1); u.kind = 1; u.a = Wv + (size_t)u.pm * TSTEP1K; u.b = XG + (size_t)u.pn * TSTEP1K; return true; }
        L -= 256; if (L >= 24) return false;
        const int tile = (int)L;
        if (tile < 20) { u.pm = 128 + (tile & 1); u.pn = tile >> 1; u.kind = 0; u.a = XG + (size_t)u.pm * TSTEP1K; u.b = Wmain + (size_t)u.pn * TSTEP1K; }
        else { const int tt = tile - 20; u.pm = tt & 1; u.pn = 128 + (tt >> 1); u.kind = 1; u.a = Wv + (size_t)u.pm * TSTEP1K; u.b = XG + (size_t)u.pn * TSTEP1K; }
        return true;
    }
};

struct SchedUp {
    const char* A; const char* Bt; int G, c, cbase;
    __device__ __forceinline__ bool next(int i, Unit& u) const {
        long L = (long)i * G + c;
        u.kind = 0; u.nt = 16; u.slice = 0; u.nsplit = 1; u.tile = 0;
        if (L < 130 * 22) { pg8::map_tile((int)L, 130, 22, u.pm, u.pn); u.pad = 254 * u.pm - 2; }
        else { L -= 130 * 22; if (L >= 44) return false; u.pm = 130 + (int)(L & 1); u.pn = (int)(L >> 1); u.pad = NP + 256 * (int)(L & 1); }
        u.a = A + (ptrdiff_t)u.pad * 2048; u.b = Bt + (size_t)u.pn * TSTEP1K; return true;
    }
};

struct EpiIn {
    static constexpr bool PERM = true, AFTER_DRAIN = false;
    int l;
    __device__ __forceinline__ void pre_issue(const Unit& u, int ui, int wid, int lane, LAS unsigned char* lds) const {
        pre_rows((const float*)((unsigned char*)karg(20) + WS_SSQ), 256 * (u.kind == 0 ? u.pm : u.pn), ui, wid, lane, lds);
    }
    __device__ __forceinline__ void operator()(f32x4 (&acc)[2][2][4][2], const Unit& u, int ui, int wr, int wc, int fr, int fq, int lane, LAS unsigned char* lds) const {
        asm volatile("" : "+v"(fr), "+v"(fq), "+v"(lane));
        unsigned char* wsb = (unsigned char*)karg(20); float* outb = (float*)karg(19);
        const LAS f32x4* pre = (const LAS f32x4*)(lds + EXTRA_OFF + X_PRE) + (ui & 1) * 256; bf16_t* P5 = (bf16_t*)(wsb + WS_P5); bf16_t* VT = (bf16_t*)(wsb + WS_VT); bf16_t* KF = (bf16_t*)(wsb + WS_KF);
        float* okp = outb + O_KP + (size_t)l * NB * 512 * 512; float* ovp = outb + O_VP + (size_t)l * NB * 512 * 512;
        float* oks = outb + O_KS + (size_t)l * SB * SS * 512; float* ovs = outb + O_VS + (size_t)l * SB * SS * 512;
        asm volatile("s_waitcnt lgkmcnt(0)" ::: "memory"); __builtin_amdgcn_s_barrier(); asm volatile("" ::: "memory");
        if (u.kind == 0) {
            const int rbase = u.pm * 256 + wr * 64;
            const float st0 = rstd_of(pre[64 * wr + lane]), st1 = rstd_of(pre[128 + 64 * wr + lane]);
            const bool samp = u.pm >= 128;
            const bool kout = (u.pn == 2 || u.pn == 3) && (samp || (u.pm & 7) >= 6);
#pragma unroll
            for (int ai = 0; ai < 2; ++ai)
#pragma unroll
                for (int m = 0; m < 4; ++m) {
                    const float rs = __shfl(ai ? st1 : st0, 16 * m + fr);
                    const int row = rbase + 128 * ai + 16 * m + fr;
                    if (u.pn >= 6) {
                        const f32x4 p0 = (acc[ai][0][m][0] * rs) * (acc[ai][1][m][0] * rs), p1 = (acc[ai][0][m][1] * rs) * (acc[ai][1][m][1] * rs);
                        u32x4 w; w.x = cvt_pk_bf16(p0[0], p0[1]); w.y = cvt_pk_bf16(p0[2], p0[3]); w.z = cvt_pk_bf16(p1[0], p1[1]); w.w = cvt_pk_bf16(p1[2], p1[3]);
                        *(u32x4*)(P5 + (unsigned)(row * PW + 1536 + (u.pn - 6) * 128 + wc * 32 + 8 * fq)) = w;
                    } else
#pragma unroll
                    for (int bj = 0; bj < 2; ++bj) {
                        const f32x4 v0 = acc[ai][bj][m][0] * rs, v1 = acc[ai][bj][m][1] * rs;
                        const int col0 = u.pn * 256 + bj * 128 + wc * 32 + 8 * fq;
                        u32x4 w; w.x = cvt_pk_bf16(v0[0], v0[1]); w.y = cvt_pk_bf16(v0[2], v0[3]); w.z = cvt_pk_bf16(v1[0], v1[1]); w.w = cvt_pk_bf16(v1[2], v1[3]);
                        if (u.pn == 2 || u.pn == 3) {
                            const unsigned c = (unsigned)(col0 - 512), hh = c >> 6, d0 = c & 63;
                            *(u32x4*)(KF + (unsigned)((((((unsigned)row >> 5) * 8 + hh) * 4 + (d0 >> 4)) * 32 + ((unsigned)row & 31)) * 16 + (d0 & 15))) = w;
                        } else
                        *(u32x4*)(P5 + (unsigned)(row * PW + col0)) = w;
                        if (kout) {
                            const unsigned ridx = samp ? (unsigned)(row - NP) : (unsigned)((u.pm >> 3) * 512 + (row & 2047) - 1536);
                            float* o = (samp ? oks : okp) + (unsigned)(ridx * 512 + (col0 - 512));
                            *(f32x4*)o = v0; *(f32x4*)(o + 4) = v1;
                        }
                    }
                    __builtin_amdgcn_sched_barrier(0);
                }
        } else {
            const int tok0 = u.pn * 256 + wc * 32;
            const float st = rstd_of(pre[32 * wc + 128 * (lane >> 5) + (lane & 31)]);
            float cs[2][2][4];
#pragma unroll
            for (int bj = 0; bj < 2; ++bj)
#pragma unroll
                for (int n = 0; n < 2; ++n)
#pragma unroll
                    for (int j = 0; j < 4; ++j) cs[bj][n][j] = __shfl(st, 32 * bj + 8 * fq + 4 * n + j);
            const bool samp = u.pn >= 128; const bool vout = samp || (u.pn & 7) >= 6;
#pragma unroll
            for (int ai = 0; ai < 2; ++ai)
#pragma unroll
                for (int m = 0; m < 4; ++m) {
                    const int ch = u.pm * 256 + 128 * ai + 64 * wr + 16 * m + fr;
#pragma unroll
                    for (int bj = 0; bj < 2; ++bj) {
                        f32x4 v0 = acc[ai][bj][m][0], v1 = acc[ai][bj][m][1];
#pragma unroll
                        for (int j = 0; j < 4; ++j) { v0[j] *= cs[bj][0][j]; v1[j] *= cs[bj][1][j]; }
                        const int tokc = u.pn * 256 + bj * 128 + wc * 32 + 8 * fq;
                        { u32x2 w0, w1; w0.x = cvt_pk_bf16(v0[0], v0[1]); w0.y = cvt_pk_bf16(v0[2], v0[3]); w1.x = cvt_pk_bf16(v1[0], v1[1]); w1.y = cvt_pk_bf16(v1[2], v1[3]);
                          const unsigned vb = (((unsigned)tokc >> 4) * 512 + (unsigned)ch) * 16 + 4 * (((unsigned)tokc >> 3) & 1);
                          *(u32x2*)(VT + vb) = w0; *(u32x2*)(VT + vb + 8) = w1; }
                        if (vout) {
                            const unsigned ridx = samp ? (unsigned)(tokc - NP) : (unsigned)((u.pn >> 3) * 512 + (tokc & 2047) - 1536);
                            float* ob = samp ? ovs : ovp; const unsigned oi = ridx * 512 + ch;
#pragma unroll
                            for (int j = 0; j < 4; ++j) { ob[oi + j * 512] = v0[j]; ob[oi + (4 + j) * 512] = v1[j]; }
                        }
                    }
                    __builtin_amdgcn_sched_barrier(0);
                }
        }
    }
};

struct EpiRes {
    static constexpr bool PERM = true, AFTER_DRAIN = false;
    bf16_t* XG; float* ssq4;
    __device__ __forceinline__ void pre_issue(const Unit&, int, int, int, LAS unsigned char*) const {}
    __device__ __forceinline__ void operator()(f32x4 (&acc)[2][2][4][2], const Unit& u, int ui, int wr, int wc, int fr, int fq, int lane, LAS unsigned char* lds) const {
        asm volatile("" : "+v"(fr), "+v"(fq), "+v"(lane));
        const unsigned cbase = (unsigned)(u.pn * 256 + wc * 32 + 8 * fq), rb = (unsigned)(u.pm * 256 + 64 * wr + fr);
        LAS float* red = (LAS float*)(lds + EXTRA_OFF);
        u32x4 xin[2][2];
#define EPR_LOAD(IT, BUF) do { const unsigned row_ = rb + 128 * ((IT) >> 2) + 16 * ((IT) & 3); _Pragma("unroll") for (int bj = 0; bj < 2; ++bj) \
            xin[BUF][bj] = *(const u32x4*)(XG + (row_ * DM + cbase + bj * 128)); } while (0)
        EPR_LOAD(0, 0);
#pragma unroll
        for (int it = 0; it < 8; ++it) {
            if (it + 1 < 8) EPR_LOAD(it + 1, (it + 1) & 1);
            __builtin_amdgcn_sched_barrier(0);
            const int ai = it >> 2, m = it & 3;
            const unsigned row = rb + 128 * ai + 16 * m;
            float ss = 0.f;
#pragma unroll
            for (int bj = 0; bj < 2; ++bj) {
                const u32x4 xw = xin[it & 1][bj];
                f32x4 v0, v1;
                v0[0] = __builtin_bit_cast(float, xw.x << 16); v0[1] = __builtin_bit_cast(float, xw.x & 0xffff0000u); v0[2] = __builtin_bit_cast(float, xw.y << 16); v0[3] = __builtin_bit_cast(float, xw.y & 0xffff0000u);
                v1[0] = __builtin_bit_cast(float, xw.z << 16); v1[1] = __builtin_bit_cast(float, xw.z & 0xffff0000u); v1[2] = __builtin_bit_cast(float, xw.w << 16); v1[3] = __builtin_bit_cast(float, xw.w & 0xffff0000u);
                v0 += acc[ai][bj][m][0]; v1 += acc[ai][bj][m][1];
                ss += ((v0[0] * v0[0] + v0[1] * v0[1]) + (v0[2] * v0[2] + v0[3] * v0[3])) + ((v1[0] * v1[0] + v1[1] * v1[1]) + (v1[2] * v1[2] + v1[3] * v1[3]));
                u32x4 w; w.x = cvt_pk_bf16(v0[0], v0[1]); w.y = cvt_pk_bf16(v0[2], v0[3]); w.z = cvt_pk_bf16(v1[0], v1[1]); w.w = cvt_pk_bf16(v1[2], v1[3]);
                *(u32x4*)(XG + (row * DM + cbase + bj * 128)) = w;
            }
            ss += __shfl_xor(ss, 16); ss += __shfl_xor(ss, 32);
            if (fq == 0) red[(128 * ai + 64 * wr + 16 * m + fr) * 4 + wc] = ss;
            __builtin_amdgcn_sched_barrier(0);
        }
#undef EPR_LOAD
        asm volatile("s_waitcnt lgkmcnt(0)" ::: "memory"); __builtin_amdgcn_s_barrier(); asm volatile("" ::: "memory");
        { const int t_ = (wr * 4 + wc) * 64 + lane; if (t_ < 256) { const f32x4 p = *(const LAS f32x4*)(red + 4 * t_); ssq4[(unsigned)((u.pm * 256 + t_) * 4 + u.pn)] = (p.x + p.y) + (p.z + p.w); } }
    }
};

struct EpiUp {
    static constexpr bool PERM = true, AFTER_DRAIN = false;
    int l;
    __device__ __forceinline__ void pre_issue(const Unit& u, int ui, int wid, int lane, LAS unsigned char* lds) const {
        pre_rows((const float*)((unsigned char*)karg(20) + WS_SSQ) + (1u << 18), u.pad, ui, wid, lane, lds);
        const int arr = wid >> 1, hf = wid & 1;
        const float* src = (arr < 3 ? karg(15) + (size_t)l * 3 * UPW + (size_t)arr * UPW : karg(16) + (size_t)l * UPW) + hf * DFF + u.pn * 128 + lane;
        LAS unsigned* wd = (LAS unsigned*)(lds + EXTRA_OFF + X_W) + (ui & 1) * 1024 + arr * 256 + hf * 128;
        __builtin_amdgcn_global_load_lds((const unsigned*)src, wd, 4, 0, 0);
        __builtin_amdgcn_global_load_lds((const unsigned*)(src + 64), wd + 64, 4, 0, 0);
    }
    __device__ __forceinline__ void operator()(f32x4 (&acc)[2][2][4][2], const Unit& u, int ui, int wr, int wc, int fr, int fq, int lane, LAS unsigned char* lds) const {
        asm volatile("" : "+v"(fr), "+v"(fq), "+v"(lane));
        unsigned char* wsb = (unsigned char*)karg(20); float* outb = (float*)karg(19);
        const LAS f32x4* pre = (const LAS f32x4*)(lds + EXTRA_OFF + X_PRE) + (ui & 1) * 256; (void)wsb;
        float* offs = outb + O_FS + (size_t)l * SB * 2 * UPW;
        const int rbase = u.pad + wr * 64;
        const bool samp = u.pm >= 130;
        asm volatile("s_waitcnt lgkmcnt(0)" ::: "memory"); __builtin_amdgcn_s_barrier(); asm volatile("" ::: "memory");
        const float st0 = rstd_of(pre[64 * wr + lane]), st1 = rstd_of(pre[128 + 64 * wr + lane]);
        LAS float* halo = (LAS float*)(lds + EXTRA_OFF);
        const int ccol = wc * 32 + 8 * fq;
#pragma unroll
        for (int ai = 0; ai < 2; ++ai)
#pragma unroll
            for (int m = 0; m < 4; ++m) {
                const float rs = __shfl(ai ? st1 : st0, 16 * m + fr);
#pragma unroll
                for (int bj = 0; bj < 2; ++bj)
#pragma unroll
                    for (int n = 0; n < 2; ++n) acc[ai][bj][m][n] *= rs;
            }
        if (fr >= 14) {
#pragma unroll
            for (int ai = 0; ai < 2; ++ai)
#pragma unroll
                for (int bj = 0; bj < 2; ++bj)
#pragma unroll
                    for (int n = 0; n < 2; ++n) *(LAS f32x4*)(halo + ((2 * ai + wr) * 2 + (fr - 14)) * 256 + bj * 128 + ccol + 4 * n) = acc[ai][bj][3][n];
        }
        if (!samp) {
        } else if (fr >= 14) {
#pragma unroll
            for (int ai = 0; ai < 2; ++ai)
#pragma unroll
                for (int m = 0; m < 4; ++m) {
                    const int s = (rbase + 128 * ai + 16 * m - NP) >> 4;
#pragma unroll
                    for (int bj = 0; bj < 2; ++bj)
#pragma unroll
                        for (int n = 0; n < 2; ++n) *(f32x4*)(offs + (unsigned)((s * 2 + (fr - 14)) * UPW + bj * DFF + u.pn * 128 + ccol + 4 * n)) = acc[ai][bj][m][n];
                }
        }
        asm volatile("s_waitcnt lgkmcnt(0)" ::: "memory"); __builtin_amdgcn_s_barrier(); asm volatile("" ::: "memory");
        const LAS float* wl_ = (const LAS float*)(lds + EXTRA_OFF + X_W) + (ui & 1) * 1024;
        const int lo2 = u.pad + 2, mb = ((lo2 + 2044) >> 11) << 11; const bool bnd = mb <= lo2 + 255;
        if (samp) conv_act<true, false>(acc, u, wr, fr, rbase, ccol, halo, wl_); else if (bnd) conv_act<false, true>(acc, u, wr, fr, rbase, ccol, halo, wl_); else conv_act<false, false>(acc, u, wr, fr, rbase, ccol, halo, wl_);
    }
    template <bool SAMP, bool BND>
    __device__ __forceinline__ void conv_act(const f32x4 (&acc)[2][2][4][2], const Unit& u, int wr, int fr, int rbase, int ccol, LAS float* halo, const LAS float* wl_) const {
        unsigned char* wsb = (unsigned char*)karg(20);
        bf16_t* ACT = (bf16_t*)(wsb + WS_ACT); const float* sffn = karg(5) + (size_t)l * SB * 2 * UPW; float* offp = (float*)karg(19) + O_FP + (size_t)l * NB * 2 * UPW;
        u32x2 keep[2][4];
#pragma unroll
        for (int n = 0; n < 2; ++n) {
            f32x4 W0[2], W1[2], W2[2], BB[2];
#pragma unroll
            for (int bj = 0; bj < 2; ++bj) {
                const int tc = bj * 128 + ccol + 4 * n;
                W0[bj] = *(const LAS f32x4*)(wl_ + tc); W1[bj] = *(const LAS f32x4*)(wl_ + 256 + tc); W2[bj] = *(const LAS f32x4*)(wl_ + 512 + tc); BB[bj] = *(const LAS f32x4*)(wl_ + 768 + tc);
            }
#pragma unroll
            for (int ai = 0; ai < 2; ++ai)
#pragma unroll
                for (int m = 0; m < 4; ++m) {
                    const int row = rbase + 128 * ai + 16 * m + fr;
                    const bool ok = SAMP || (row < NP && !(ai == 0 && m == 0 && wr == 0 && fr < 2));
                    const int t4 = (row + 2) & 2047;
                    const float z1 = (BND && t4 == 2) ? 0.f : 1.f, z2 = (BND && (t4 == 2 || t4 == 3)) ? 0.f : 1.f;
                    f32x4 a[2];
#pragma unroll
                    for (int bj = 0; bj < 2; ++bj) {
                        f32x4 prev;
                        if (SAMP) { const int s = (rbase + 128 * ai + 16 * m - NP) >> 4; prev = *(const f32x4*)(sffn + (unsigned)((s * 2 + (fr & 1)) * UPW + bj * DFF + u.pn * 128 + ccol + 4 * n)); }
                        else if (m > 0) prev = acc[ai][bj][m > 0 ? m - 1 : 0][n];
                        else { const int blk = 2 * ai + wr; prev = (f32x4){0.f, 0.f, 0.f, 0.f}; if (blk > 0) prev = *(const LAS f32x4*)(halo + ((blk - 1) * 2 + (fr & 1)) * 256 + bj * 128 + ccol + 4 * n); }
                        const f32x4 cur = acc[ai][bj][m][n];
#pragma unroll
                        for (int j = 0; j < 4; ++j) {
                            const float p1 = dppf<0x111>(dppf<0x121>(0.f, prev[j]), cur[j]);
                            const float p2 = dppf<0x112>(dppf<0x122>(0.f, prev[j]), cur[j]);
                            a[bj][j] = BB[bj][j] + W2[bj][j] * cur[j] + W1[bj][j] * (BND ? p1 * z1 : p1) + W0[bj][j] * (BND ? p2 * z2 : p2);
                        }
                        if (BND) { if (ok && t4 < 2 && row >= 2046) *(f32x4*)(offp + (unsigned)(((((row + 2) >> 11) - 1) * 2 + t4) * UPW + bj * DFF + u.pn * 128 + ccol + 4 * n)) = cur; }
                        __builtin_amdgcn_sched_barrier(0);
                    }
                    float o[4];
#pragma unroll
                    for (int j = 0; j < 4; ++j) { const float g = a[0][j], v = a[1][j]; o[j] = g * __builtin_amdgcn_rcpf(1.0f + __builtin_amdgcn_exp2f(-g * LOG2E)) * v; }
                    u32x2 w; w.x = cvt_pk_bf16(o[0], o[1]); w.y = cvt_pk_bf16(o[2], o[3]);
                    if (n == 0) keep[ai][m] = w;
                    else if (ok) { u32x4 w4; w4.x = keep[ai][m].x; w4.y = keep[ai][m].y; w4.z = w.x; w4.w = w.y; *(u32x4*)(ACT + (unsigned)(row * DFF + u.pn * 128 + ccol)) = w4; }
                    __builtin_amdgcn_sched_barrier(0);
                }
        }
    }
};
template <int NQB>
__device__ __forceinline__ void attn_wave(const bf16_t* qp, const bf16_t* kpast, const bf16_t* vpast, int Tpast, const bf16_t* kcur, const bf16_t* vcur, int Tcur, int hd,
                                          int t0, int nvalid_cur, int nq, const LAS float* tbl, bf16_t* outp, const float* gvec, int lane, LAS bf16x8* qlds) {
    const int r = lane & 31, h = lane >> 5;
    constexpr float SC = 0.125f * LOG2E;
#pragma unroll
    for (int qb = 0; qb < NQB; ++qb)
#pragma unroll
        for (int ks = 0; ks < 4; ++ks) qlds[(qb * 4 + ks) * 64 + lane] = *(const bf16x8*)(qp + (size_t)(32 * qb + r) * PW + 16 * ks + 8 * h);
    f32x16 o[2][NQB]; float mrun[NQB], lrun[NQB];
#pragma unroll
    for (int qb = 0; qb < NQB; ++qb) { mrun[qb] = -1e30f; lrun[qb] = 0.f;
#pragma unroll
        for (int db = 0; db < 2; ++db)
#pragma unroll
            for (int i = 0; i < 16; ++i) o[db][qb][i] = 0.f; }
    const float bconst = tbl[191];
    const unsigned vlane = (unsigned)(r * 16 + 8 * h);
    bf16x8 kf[2][4];
#define ATTN_KLOAD(TT) do { const bf16_t* kb_ = (TT) < 8 ? kpast : kcur; const unsigned T0_ = (unsigned)((TT) < 8 ? Tpast + 64 * (TT) : Tcur); \
        _Pragma("unroll") for (int kb = 0; kb < 2; ++kb) { const unsigned T_ = T0_ + 32 * kb + r; const unsigned ko_ = ((T_ >> 5) * 32 + hd * 4) * 512 + (T_ & 31) * 16 + 8 * h; \
            _Pragma("unroll") for (int ks = 0; ks < 4; ++ks) kf[kb][ks] = *(const bf16x8*)(kb_ + ko_ + ks * 512); } } while (0)
    ATTN_KLOAD(t0);
    for (int t = t0; t <= 8; ++t) {
        const bf16_t* vp = t < 8 ? vpast : vcur; const unsigned Tv = (unsigned)(t < 8 ? Tpast + 64 * t : Tcur);
        bf16x8 vf[2][2][2];
#pragma unroll
        for (int kb = 0; kb < 2; ++kb)
#pragma unroll
            for (int sx = 0; sx < 2; ++sx)
#pragma unroll
                for (int db = 0; db < 2; ++db)
                    vf[kb][sx][db] = *(const bf16x8*)(vp + (size_t)(((Tv >> 4) + 2 * kb + sx) * 512 + hd * 64 + 32 * db) * 16 + vlane);
        __builtin_amdgcn_sched_barrier(0);
        const int koff = -512 + 64 * t;
#pragma unroll
        for (int qb = 0; qb < NQB; ++qb) {
            f32x16 s[2];
#pragma unroll
            for (int kb = 0; kb < 2; ++kb)
#pragma unroll
                for (int i = 0; i < 16; ++i) s[kb][i] = 0.f;
#pragma unroll
            for (int ks = 0; ks < 4; ++ks) {
                const bf16x8 qf = qlds[(qb * 4 + ks) * 64 + lane];
                s[0] = __builtin_amdgcn_mfma_f32_32x32x16_bf16(kf[0][ks], qf, s[0], 0, 0, 0);
                s[1] = __builtin_amdgcn_mfma_f32_32x32x16_bf16(kf[1][ks], qf, s[1], 0, 0, 0);
            }
            __builtin_amdgcn_sched_barrier(0);
            if (qb == NQB - 1 && t < 8) {
                ATTN_KLOAD(t + 1);
                __builtin_amdgcn_sched_barrier(0);
            }
            float mx = mrun[qb];
            if (t <= 5) {
#pragma unroll
                for (int kb = 0; kb < 2; ++kb)
#pragma unroll
                    for (int i = 0; i < 16; ++i) { const float v = s[kb][i] * SC + bconst; s[kb][i] = v; mx = fmaxf(mx, v); }
            } else {
                const LAS float* tl = tbl + (32 * qb + r - koff - 4 * h);
#pragma unroll
                for (int kb = 0; kb < 2; ++kb)
#pragma unroll
                    for (int i = 0; i < 16; ++i) {
                        const int kin = 32 * kb + (i & 3) + 8 * (i >> 2);
                        float v = s[kb][i] * SC + tl[63 - kin];
                        if (t == 8 && (kin + 4 * h) >= nvalid_cur) v = -1e30f;
                        s[kb][i] = v; mx = fmaxf(mx, v);
                    }
            }
            mx = fmaxf(mx, __shfl_xor(mx, 32));
            const float alpha = __builtin_amdgcn_exp2f(mrun[qb] - mx); mrun[qb] = mx;
            float ps = 0.f;
#pragma unroll
            for (int kb = 0; kb < 2; ++kb)
#pragma unroll
                for (int i = 0; i < 16; ++i) { const float p = __builtin_amdgcn_exp2f(s[kb][i] - mx); s[kb][i] = p; ps += p; }
            lrun[qb] = lrun[qb] * alpha + ps;
#pragma unroll
            for (int db = 0; db < 2; ++db)
#pragma unroll
                for (int i = 0; i < 16; ++i) o[db][qb][i] *= alpha;
#pragma unroll
            for (int kb = 0; kb < 2; ++kb)
#pragma unroll
                for (int sx = 0; sx < 2; ++sx) {
                    u32x4 w; const f32x16& sv = s[kb];
                    w.x = cvt_pk_bf16(sv[8 * sx + 0], sv[8 * sx + 1]); w.y = cvt_pk_bf16(sv[8 * sx + 2], sv[8 * sx + 3]);
                    w.z = cvt_pk_bf16(sv[8 * sx + 4], sv[8 * sx + 5]); w.w = cvt_pk_bf16(sv[8 * sx + 6], sv[8 * sx + 7]);
                    const bf16x8 pf = __builtin_bit_cast(bf16x8, w);
#pragma unroll
                    for (int db = 0; db < 2; ++db) o[db][qb] = __builtin_amdgcn_mfma_f32_32x32x16_bf16(vf[kb][sx][db], pf, o[db][qb], 0, 0, 0);
                }
            __builtin_amdgcn_sched_barrier(0);
        }
    }
    int lane2 = lane; asm volatile("" : "+v"(lane2));
    const int r2 = lane2 & 31, h2 = lane2 >> 5;
#pragma unroll
    for (int qb = 0; qb < NQB; ++qb) {
        float l = lrun[qb]; l += __shfl_xor(l, 32);
        const float inv = 1.0f / l; float ss = 0.f;
#pragma unroll
        for (int db = 0; db < 2; ++db)
#pragma unroll
            for (int i = 0; i < 16; ++i) { const float v = o[db][qb][i] * inv; o[db][qb][i] = v; ss += v * v; }
        ss += __shfl_xor(ss, 32);
        const float rn = rsqrtf(ss * (1.0f / 64.0f) + EPS);
        const int q = 32 * qb + r2;
#pragma unroll
        for (int db = 0; db < 2; ++db) {
            u32x2 pk[4];
#pragma unroll
            for (int g4 = 0; g4 < 4; ++g4) {
                pk[g4].x = cvt_pk_bf16(o[db][qb][4 * g4 + 0] * rn, o[db][qb][4 * g4 + 1] * rn);
                pk[g4].y = cvt_pk_bf16(o[db][qb][4 * g4 + 2] * rn, o[db][qb][4 * g4 + 3] * rn);
            }
#pragma unroll
            for (int k = 0; k < 2; ++k) {
                const u32x2 lo = pk[2 * k], hi = pk[2 * k + 1];
                const u32x2 snd = h2 ? lo : hi;
                u32x2 rcv; rcv.x = (unsigned)__shfl_xor((int)snd.x, 32); rcv.y = (unsigned)__shfl_xor((int)snd.y, 32);
                u32x4 w;
                if (h2) { w.x = rcv.x; w.y = rcv.y; w.z = hi.x; w.w = hi.y; } else { w.x = lo.x; w.y = lo.y; w.z = rcv.x; w.w = rcv.y; }
                if (q < nq) *(u32x4*)(outp + (unsigned)(q * DM + 32 * db + 16 * k + 8 * h2)) = w;
            }
        }
    }
}

__device__ __forceinline__ void unp8(const u32x4 w, float (&v)[8]) {
    v[0] = __builtin_bit_cast(float, w.x << 16); v[1] = __builtin_bit_cast(float, w.x & 0xffff0000u);
    v[2] = __builtin_bit_cast(float, w.y << 16); v[3] = __builtin_bit_cast(float, w.y & 0xffff0000u);
    v[4] = __builtin_bit_cast(float, w.z << 16); v[5] = __builtin_bit_cast(float, w.z & 0xffff0000u);
    v[6] = __builtin_bit_cast(float, w.w << 16); v[7] = __builtin_bit_cast(float, w.w & 0xffff0000u);
}
__device__ __forceinline__ void ld8(const bf16_t* p, float (&v)[8]) {
    const u32x4 w = *(const u32x4*)p;
    v[0] = __builtin_bit_cast(float, w.x << 16); v[1] = __builtin_bit_cast(float, w.x & 0xffff0000u);
    v[2] = __builtin_bit_cast(float, w.y << 16); v[3] = __builtin_bit_cast(float, w.y & 0xffff0000u);
    v[4] = __builtin_bit_cast(float, w.z << 16); v[5] = __builtin_bit_cast(float, w.z & 0xffff0000u);
    v[6] = __builtin_bit_cast(float, w.w << 16); v[7] = __builtin_bit_cast(float, w.w & 0xffff0000u);
}
__device__ __forceinline__ void conv_run(int run, const bf16_t* P5, bf16_t* MIX, const float* cw, const float* cg_, const float* smix, float* ocp, float* ocs, int lane) {
    const int R0 = run * 16, c0 = 8 * lane;
    float w0[8], w1[8], w2[8], gg[8], h0[8], h1[8];
#pragma unroll
    for (int j = 0; j < 8; ++j) { w0[j] = cw[c0 + j]; w1[j] = cw[512 + c0 + j]; w2[j] = cw[1024 + c0 + j]; gg[j] = cg_[c0 + j]; }
    const bool samp = R0 >= NP;
    if (samp) { const int s = (R0 - NP) >> 4;
#pragma unroll
        for (int j = 0; j < 8; ++j) { h0[j] = smix[(size_t)(s * 2 + 0) * 512 + c0 + j]; h1[j] = smix[(size_t)(s * 2 + 1) * 512 + c0 + j]; }
    } else if ((R0 & 2047) == 0) {
#pragma unroll
        for (int j = 0; j < 8; ++j) { h0[j] = 0.f; h1[j] = 0.f; }
    } else {
        ld8(P5 + (size_t)(R0 - 2) * PW + 1536 + c0, h0);
        ld8(P5 + (size_t)(R0 - 1) * PW + 1536 + c0, h1);
    }
    for (int i0 = 0; i0 < 16; i0 += 8) {
        u32x4 rb[8], rc[8];
#pragma unroll
        for (int k = 0; k < 8; ++k) { const bf16_t* rp = P5 + (size_t)(R0 + i0 + k) * PW + c0; rb[k] = *(const u32x4*)(rp + 1024); rc[k] = *(const u32x4*)(rp + 1536); }
#pragma unroll
        for (int k = 0; k < 8; ++k) {
            float bv[8], cv[8], z[8];
            unp8(rb[k], bv); unp8(rc[k], cv);
            float ss = 0.f;
#pragma unroll
            for (int j = 0; j < 8; ++j) { const float cu = cv[j]; z[j] = bv[j] * (w0[j] * h0[j] + w1[j] * h1[j] + w2[j] * cu); ss += z[j] * z[j]; h0[j] = h1[j]; h1[j] = cu; }
            ss += __shfl_xor(ss, 1); ss += __shfl_xor(ss, 2); ss += __shfl_xor(ss, 4);
            const float rn = rsqrtf(ss * (1.0f / 64.0f) + EPS);
                u32x4 w; w.x = cvt_pk_bf16(z[0] * rn, z[1] * rn); w.y = cvt_pk_bf16(z[2] * rn, z[3] * rn);
            w.z = cvt_pk_bf16(z[4] * rn, z[5] * rn); w.w = cvt_pk_bf16(z[6] * rn, z[7] * rn);
            *(u32x4*)(MIX + (size_t)(R0 + i0 + k) * DM + 512 + c0) = w;
        }
    }
    float* op = nullptr;
    if (samp) op = ocs + (size_t)((R0 - NP) >> 4) * 1024;
    else if (((R0 + 16) & 2047) == 0) op = ocp + (size_t)(R0 >> 11) * 1024;
    if (op) {
#pragma unroll
        for (int j = 0; j < 8; ++j) { op[c0 + j] = h0[j]; op[512 + c0 + j] = h1[j]; }
    }
}

__device__ __forceinline__ unsigned f2bf(float f) { unsigned u = __builtin_bit_cast(unsigned, f); return (u + 0x7fffu + ((u >> 16) & 1u)) >> 16; }
__device__ __forceinline__ unsigned pk2(float lo, float hi) { return f2bf(lo) | (f2bf(hi) << 16); }
__device__ __forceinline__ void transpose_item(const float* W, int N, int k0, int n0, bf16_t* dst, int ldd, LAS float* scr, int lane, const float* gk = nullptr) {
#pragma unroll 8
    for (int i = 0; i < 32; ++i) { const int kk = 2 * i + (lane >> 5); scr[kk * 33 + (lane & 31)] = W[(size_t)(k0 + kk) * N + n0 + (lane & 31)] * (gk ? gk[k0 + kk] : 1.0f); }
    asm volatile("s_waitcnt lgkmcnt(0)" ::: "memory");
    const int c = lane & 7;
#pragma unroll
    for (int j = 0; j < 4; ++j) { const int n = (lane >> 3) + 8 * j; const LAS float* s = scr + (8 * c) * 33 + n;
        u32x4 o; o.x = pk2(s[0 * 33], s[1 * 33]); o.y = pk2(s[2 * 33], s[3 * 33]); o.z = pk2(s[4 * 33], s[5 * 33]); o.w = pk2(s[6 * 33], s[7 * 33]);
        *(u32x4*)(dst + (size_t)n * ldd + k0 + 8 * c) = o; }
    asm volatile("s_waitcnt lgkmcnt(0)" ::: "memory");
}

__device__ __forceinline__ void transpose_item_v(const float* W, int k0, int n0, bf16_t* dst, int Tbase, LAS float* scr, int lane) {
#pragma unroll 8
    for (int i = 0; i < 32; ++i) { const int kk = 2 * i + (lane >> 5); scr[kk * 33 + (lane & 31)] = W[(size_t)(k0 + kk) * 512 + n0 + (lane & 31)]; }
    asm volatile("s_waitcnt lgkmcnt(0)" ::: "memory");
    const int c = lane & 7;
#pragma unroll
    for (int j = 0; j < 4; ++j) { const int n = (lane >> 3) + 8 * j; const LAS float* s = scr + (8 * c) * 33 + n;
        u32x2 o0, o1; o0.x = pk2(s[0 * 33], s[1 * 33]); o0.y = pk2(s[2 * 33], s[3 * 33]); o1.x = pk2(s[4 * 33], s[5 * 33]); o1.y = pk2(s[6 * 33], s[7 * 33]);
        const unsigned T = (unsigned)(Tbase + k0 + 8 * c);
        const unsigned vb = ((T >> 4) * 512 + (unsigned)(n0 + n)) * 16 + 4 * ((T >> 3) & 1);
        *(u32x2*)(dst + vb) = o0; *(u32x2*)(dst + vb + 8) = o1; }
    asm volatile("s_waitcnt lgkmcnt(0)" ::: "memory");
}
#define XB_TMO      128
#define XB_XCNT(j)  (256  + 64 * (j))
#define XB_XSUB(j)  (1280 + 64 * (j))
#define XB_XGEN(j)  (2304 + 64 * (j))
#define XB_TOP      3328
#define XB_TOPGEN   3392
#define XCD_BAR_WORDS 3456
#define XB_SPIN_CAP (1u << 18)

__device__ __forceinline__ unsigned xb_ld(unsigned* p)              { return __hip_atomic_load(p, __ATOMIC_RELAXED, __HIP_MEMORY_SCOPE_AGENT); }
__device__ __forceinline__ unsigned xb_add(unsigned* p, unsigned v) { return __hip_atomic_fetch_add(p, v, __ATOMIC_RELAXED, __HIP_MEMORY_SCOPE_AGENT); }
__device__ __forceinline__ unsigned xb_xcc_id() { return (unsigned)__builtin_amdgcn_s_getreg((3 << 11) | 20) & 0xFu; }
#define XB_SPIN(cond, bar) do { unsigned _sp = 0; while (cond) { __builtin_amdgcn_s_sleep(1); \
    if ((++_sp & 255u) == 0u) { if (xb_ld(&(bar)[XB_TMO])) break; if (_sp > XB_SPIN_CAP) { atomicAdd(&(bar)[XB_TMO], 1u); break; } } } } while (0)

struct XcdBarrier {
    unsigned* bar; unsigned x;
    volatile LAS unsigned* st;
};

__device__ __forceinline__ XcdBarrier xcd_barrier_post(unsigned* bar, volatile LAS unsigned* st) {
    XcdBarrier b; b.bar = bar; b.x = xb_xcc_id(); b.st = st;
    if (threadIdx.x == 0) (void)xb_add(&bar[XB_XCNT(b.x)], 1u);
    return b;
}
__device__ __forceinline__ void xcd_barrier_complete(unsigned* bar, unsigned x, unsigned& nloc, unsigned& nx) {
    const unsigned G = gridDim.x * gridDim.y * gridDim.z;
    unsigned sum, cnt, mine, sp = 0u;
    for (;;) {
        sum = 0u; cnt = 0u; mine = 0u;
#pragma unroll
        for (unsigned j = 0; j < 16; ++j) { const unsigned c = xb_ld(&bar[XB_XCNT(j)]); sum += c; cnt += (c > 0u) ? 1u : 0u; mine = (j == x) ? c : mine; }
        if (sum == G) break;
        __builtin_amdgcn_s_sleep(1);
        if ((++sp & 255u) == 0u) { if (xb_ld(&bar[XB_TMO])) break; if (sp > XB_SPIN_CAP) { atomicAdd(&bar[XB_TMO], 1u); break; } }
    }
    nloc = mine > 0u ? mine : 1u; nx = cnt > 0u ? cnt : 1u;
}

__device__ __forceinline__ void xcd_barrier(const XcdBarrier& b) {
    asm volatile("s_waitcnt vmcnt(0)" ::: "memory");
    __syncthreads();
    int t_o = threadIdx.x; asm volatile("" : "+v"(t_o));
    if (t_o == 0) {
        unsigned* bar = b.bar;
        __builtin_amdgcn_s_waitcnt(0);
        unsigned nloc = b.st[0], nx = b.st[1];
        if (nloc == 0u) { xcd_barrier_complete(bar, b.x, nloc, nx); b.st[0] = nloc; b.st[1] = nx; }
        const unsigned old = xb_add(&bar[XB_XSUB(b.x)], 1u);
        const unsigned gen = old / nloc;
        if (old + 1u == (gen + 1u) * nloc) {
            __builtin_amdgcn_fence(__ATOMIC_RELEASE, "agent");
            asm volatile("s_waitcnt vmcnt(0)" ::: "memory");
            const unsigned og = xb_add(&bar[XB_TOP], 1u);
            const unsigned tg = og / nx;
            if (og + 1u == (tg + 1u) * nx) xb_add(&bar[XB_TOPGEN], 1u);
            else XB_SPIN(xb_ld(&bar[XB_TOPGEN]) == tg, bar);
            __builtin_amdgcn_fence(__ATOMIC_ACQUIRE, "agent");
            xb_add(&bar[XB_XGEN(b.x)], 1u);
            asm volatile("s_waitcnt vmcnt(0)" ::: "memory");
        } else {
            XB_SPIN(xb_ld(&bar[XB_XGEN(b.x)]) == gen, bar);
            __builtin_amdgcn_fence(__ATOMIC_ACQUIRE, "agent");
            asm volatile("s_waitcnt vmcnt(0)" ::: "memory");
        }
    }
    __syncthreads();
}

struct Args { const float* in[19]; float* out; unsigned char* ws; };

__global__ void __launch_bounds__(512, 2) fwd_mega(Args args) {
    extern __shared__ __attribute__((aligned(16))) unsigned char lds_raw[];
    LAS unsigned char* const lds0 = (LAS unsigned char*)lds_raw;
    cg::grid_group grid = cg::this_grid();
    volatile LAS unsigned* barst = (volatile LAS unsigned*)(lds0 + EXTRA_OFF + X_BAR);
    if (threadIdx.x < 2) barst[threadIdx.x] = 0u;
    __syncthreads();
    (void)xcd_barrier_post((unsigned*)((unsigned char*)karg(20) + WS_CTL + 4096), barst);
#define GRID_BARRIER() do { XcdBarrier b_; b_.bar = (unsigned*)((unsigned char*)karg(20) + WS_CTL + 4096); b_.x = xb_xcc_id(); b_.st = (volatile LAS unsigned*)(lds0 + EXTRA_OFF + X_BAR); xcd_barrier(b_); } while (0)
    const int G = gridDim.x, bx = blockIdx.x, NGW = G * 8;
#define out ((float*)karg(19))
#define x_prompt (karg(0))
#define x_sample (karg(1))
#define cache_k (karg(2))
#define cache_v (karg(3))
#define st_mix (karg(4))
#define st_ffn (karg(5))
#define ln1 (karg(6))
#define w_in (karg(7))
#define rel_table (karg(8))
#define conv_w (karg(9))
#define attn_g (karg(10))
#define conv_g (karg(11))
#define w_out (karg(12))
#define ln2 (karg(13))
#define w_up (karg(14))
#define fconv_w (karg(15))
#define fconv_b (karg(16))
#define w_down (karg(17))
#define final_norm (karg(18))
#define X out
#define ctr ((unsigned*)(ws + WS_CTL))
#define XG ((bf16_t*)(ws + WS_XG))
#define SSQ ((float*)(ws + WS_SSQ))
#define P5 ((bf16_t*)(ws + WS_P5))
#define VT ((bf16_t*)(ws + WS_VT))
#define ACT ((bf16_t*)(ws + WS_ACT))
#define MIX ((bf16_t*)(ws + WS_MIX))
#define KC ((bf16_t*)(ws + WS_KC))
#define VCT ((bf16_t*)(ws + WS_VCT))
#define FIRST ((float*)(ws + WS_FIRST))
#define LAST ((float*)(ws + WS_LAST))
#define KFB ((bf16_t*)(ws + WS_KF))
#define CACHE_CONVERT(LL, WIDX, NW) do { \
            const float* ck = cache_k + (size_t)(LL) * SB * 512 * 512; const float* cv = cache_v + (size_t)(LL) * SB * 512 * 512; \
            for (size_t i = (size_t)((WIDX) * 512 + tid) * 4; i < (size_t)SB * 512 * 512; i += (size_t)(NW) * 512 * 4) { \
                const f32x4 v = *(const f32x4*)(ck + i); u32x2 w; w.x = cvt_pk_bf16(v[0], v[1]); w.y = cvt_pk_bf16(v[2], v[3]); \
                const unsigned T_ = (unsigned)(i >> 9), c_ = (unsigned)(i & 511), hh_ = c_ >> 6, d_ = c_ & 63; \
                *(u32x2*)(KC + (((((T_ >> 5) * 8 + hh_) * 4 + (d_ >> 4)) * 32 + (T_ & 31)) * 16 + (d_ & 15))) = w; } \
            for (int it = (WIDX) * 8 + wave; it < SB * 128; it += (NW) * 8) { const int s_ = it >> 7, r_ = it & 127, kb_ = r_ >> 4, nb_ = r_ & 15; \
                transpose_item_v(cv + (size_t)s_ * 512 * 512, 64 * kb_, 32 * nb_, VCT, s_ * 512, scr, lane); } \
        } while (0)
#define PHASE_BEGIN int tid = threadIdx.x; asm volatile("" : "+v"(tid)); const int lane = tid & 63; const int wave = __builtin_amdgcn_readfirstlane(tid >> 6); int bxp = blockIdx.x; asm volatile("" : "+s"(bxp)); (void)bxp; const int gw = bx * 8 + wave; \
    unsigned char* ws = (unsigned char*)karg(20); unsigned ldsv = (unsigned)(size_t)lds0; asm volatile("" : "+s"(ldsv)); LAS unsigned char* lds = (LAS unsigned char*)(size_t)ldsv; LAS float* scr = (LAS float*)(lds + wave * 16384); (void)lane; (void)gw; (void)scr;

#if PH & 1
    {   PHASE_BEGIN
    if (bx == 0 && tid < 16) ctr[tid] = 0u;
        constexpr int I_IN = 16 * 96, I_OUT = 16 * 32, I_UP = 16 * 176, I_DN = 44 * 32, I_L = I_IN + I_OUT + I_UP + I_DN;
        for (int it = gw; it < DEPTH * I_L; it += NGW) {
            const int l = it / I_L; int r = it % I_L; unsigned char* wl = ws + WS_W + (size_t)l * W_LAYER;
            if (r < I_IN) { const int kb = r / 96, nb = r % 96, n0 = 32 * nb; const int drow = n0 < 1024 ? n0 : (n0 < 1536 ? 2560 + n0 - 1024 : (n0 < 2048 ? n0 - 512 : (n0 < 2560 ? 1536 + ((n0 - 2048) >> 7) * 256 + ((n0 - 2048) & 127) : 1536 + ((n0 - 2560) >> 7) * 256 + 128 + ((n0 - 2560) & 127))));
                transpose_item(w_in + (size_t)l * DM * PROJ, PROJ, 64 * kb, n0, (bf16_t*)(wl + W_IN) + (size_t)drow * 1024, 1024, scr, lane, ln1 + (size_t)l * DM); continue; }
            r -= I_IN;
            if (r < I_OUT) { const int kb = r / 32, nb = r % 32, n0 = 32 * nb;
                transpose_item(w_out + (size_t)l * DM * DM, DM, 64 * kb, n0, (bf16_t*)(wl + W_OUT) + (size_t)n0 * 1024, 1024, scr, lane, kb < 8 ? attn_g + (size_t)l * 512 : conv_g + (size_t)l * 512 - 512); continue; }
            r -= I_OUT;
            if (r < I_UP) { const int kb = r / 176, nb = r % 176, n0 = 32 * nb; const int bj = n0 / DFF, ch = n0 % DFF; const int drow = (ch >> 7) * 256 + bj * 128 + (ch & 127);
                transpose_item(w_up + (size_t)l * DM * UPW, UPW, 64 * kb, n0, (bf16_t*)(wl + W_UP) + (size_t)drow * 1024, 1024, scr, lane, ln2 + (size_t)l * DM); continue; }
            r -= I_UP;
            { const int kb = r / 32, nb = r % 32, n0 = 32 * nb;
                transpose_item(w_down + (size_t)l * DFF * DM, DM, 64 * kb, n0, (bf16_t*)(wl + W_DOWN) + (size_t)n0 * DFF, DFF, scr, lane); }
        }
        {
            for (int row0 = gw; row0 < M; row0 += 4 * NGW) {
                f32x4 xv[4][4];
#pragma unroll
                for (int k = 0; k < 4; ++k) { const int row = row0 + k * NGW; if (row < M) { const float* xr = row < NP ? x_prompt + (size_t)row * DM : x_sample + (size_t)(row - NP) * DM;
#pragma unroll
                    for (int j = 0; j < 4; ++j) xv[k][j] = *(const f32x4*)(xr + 4 * lane + 256 * j); } }
#pragma unroll
                for (int k = 0; k < 4; ++k) { const int row = row0 + k * NGW; if (row < M) {
                    float ss = 0.f;
#pragma unroll
                    for (int j = 0; j < 4; ++j) {
                        const f32x4 v = xv[k][j];
                        ss += (v[0] * v[0] + v[1] * v[1]) + (v[2] * v[2] + v[3] * v[3]);
                        u32x2 w; w.x = cvt_pk_bf16(v[0], v[1]); w.y = cvt_pk_bf16(v[2], v[3]);
                        *(u32x2*)(XG + (size_t)row * DM + 4 * lane + 256 * j) = w;
                    }
#pragma unroll
                    for (int o = 1; o < 64; o <<= 1) ss += __shfl_xor(ss, o);
                    if (lane == 0) *(f32x4*)(SSQ + (size_t)row * 4) = (f32x4){ss, 0.f, 0.f, 0.f};
                } }
            }
        }
        CACHE_CONVERT(0, bx, G);
    }
#endif
    GRID_BARRIER();
    if (gridDim.x == 0x7fffffffu) grid.sync();

    for (int l = 0; l < DEPTH; ++l) {
#define wl (ws + WS_W + (size_t)l * W_LAYER)
#if PH & 2
        {
            PHASE_BEGIN
            SchedIn S{(const char*)XG, (const char*)(wl + W_IN), (const char*)(wl + W_IN) + (size_t)2560 * 2048, G, bxp, (l * 4 + 0) * 64};
            EpiIn E{l};
            pg8::gemm_phase<EpiIn, SchedIn, true, true>(lds, 1024, S, E);
        }
#endif
        GRID_BARRIER();
#if PH & 4
        {
            PHASE_BEGIN
            LAS float* T = (LAS float*)lds;
            for (int i = tid; i < 8 * 256; i += 512) { const int hh = i >> 8, j = i & 255; int rel = j - 63; rel = rel > 128 ? 128 : rel; T[hh * 256 + j] = rel_table[(size_t)l * 8 * 257 + hh * 257 + rel + 128] * LOG2E; }
            __syncthreads();
            for (int run = gw; run < M / 16; run += NGW)
                conv_run(run, P5, MIX, conv_w + (size_t)l * 3 * 512, conv_g + (size_t)l * 512, st_mix + (size_t)l * SB * 2 * 512, out + O_CP + (size_t)l * NB * 2 * 512, out + O_CS + (size_t)l * SB * 2 * 512, lane);
            LAS int* qslot = (LAS int*)(lds + EXTRA_OFF + 8192);
            const int hd = wave;
            for (;;) {
                __syncthreads();
                if (tid == 0) *qslot = (int)atomicAdd(ctr + 16 + l * 8 + (bx & 7), 1u);
                __syncthreads();
                const int v = *qslot;
                if (v >= 68) break;
                int ln = threadIdx.x & 63; asm volatile("" : "+v"(ln));
                const int xg = bx & 7;
                int b = 0, c = 0, s = -1;
                if (v < 48) { b = 2 * xg + v / 24; c = 8 + v % 24; }
                else if (v < 56) { const int k = v - 48; c = 7 - (k >> 1); b = 2 * xg + (k & 1); }
                else if (v < 60) { s = 4 * xg + (v - 56); }
                else { const int k = v - 60; c = 3 - (k >> 1); b = 2 * xg + (k & 1); }
                {
                    const bool smp = s >= 0;
                    const int row0 = smp ? NP + s * SS : b * SEQ + c * 64;
                    attn_wave<2>(P5 + (size_t)row0 * PW + hd * 64, smp ? KC : KFB, smp ? VCT : VT, smp ? s * 512 : row0 - 512, KFB, VT, row0, hd,
                                 (smp || c >= 8) ? 0 : 8 - c, smp ? SS : 64, smp ? SS : 64,
                                 T + hd * 256, MIX + (size_t)row0 * DM + hd * 64, attn_g + (size_t)l * 512 + hd * 64, ln, (LAS bf16x8*)(lds + 16384 + wave * 8192));
                }
            }
        }
#endif
        GRID_BARRIER();
#if PH & 8
        {
            PHASE_BEGIN
            SchedGemm S{(const char*)MIX, (const char*)(wl + W_OUT), 4, G, bxp, 16, 1, (l * 4 + 1) * 64, TSTEP1K};
            EpiRes E{XG, SSQ + (1u << 18)};
            pg8::gemm_phase<EpiRes, SchedGemm, true, true>(lds, 1024, S, E);
        }
#endif
        GRID_BARRIER();
#if PH & 16
        {
            PHASE_BEGIN
            SchedUp S{(const char*)XG, (const char*)(wl + W_UP), G, bxp, 0};
            EpiUp E{l};
            pg8::gemm_phase<EpiUp, SchedUp, true, true>(lds, 1024, S, E);
        }
#endif
        GRID_BARRIER();
#if PH & 64
        {
            PHASE_BEGIN
            SchedGemm S{(const char*)ACT, (const char*)(wl + W_DOWN), 4, G, bxp, 44, 2, (l * 4 + 3) * 64, (size_t)256 * DFF * 2};
            EpiRes E{XG, SSQ};
            pg8::gemm_phase<EpiRes, SchedGemm, true, true>(lds, DFF, S, E);
            { int bxo = blockIdx.x; asm volatile("" : "+s"(bxo)); if (l + 1 < DEPTH && bxo >= 16) { CACHE_CONVERT(l + 1, bxo - 16, G - 16); } }
        }
#endif
        GRID_BARRIER();
    }
    PHASE_BEGIN
    {
        f32x4 fg[4];
#pragma unroll
        for (int j = 0; j < 4; ++j) fg[j] = *(const f32x4*)(final_norm + 4 * lane + 256 * j);
        for (int row0 = gw; row0 < M; row0 += 4 * NGW) {
            u32x2 xw[4][4]; f32x4 pp[4];
#pragma unroll
            for (int k = 0; k < 4; ++k) { const int row = row0 + k * NGW; if (row < M) { pp[k] = *(const f32x4*)(SSQ + (size_t)row * 4);
#pragma unroll
                for (int j = 0; j < 4; ++j) xw[k][j] = *(const u32x2*)(XG + (size_t)row * DM + 4 * lane + 256 * j); } }
#pragma unroll
            for (int k = 0; k < 4; ++k) { const int row = row0 + k * NGW; if (row < M) { const float rs = rstd_of(pp[k]);
#pragma unroll
                for (int j = 0; j < 4; ++j) { const u32x2 w = xw[k][j]; f32x4 v; v[0] = __builtin_bit_cast(float, w.x << 16); v[1] = __builtin_bit_cast(float, w.x & 0xffff0000u); v[2] = __builtin_bit_cast(float, w.y << 16); v[3] = __builtin_bit_cast(float, w.y & 0xffff0000u);
                    *(f32x4*)(X + (size_t)row * DM + 4 * lane + 256 * j) = v * rs * fg[j]; } } }
        }
    }
}

#undef out
#undef X
#undef ctr
#undef wl
extern "C" void kernel_launch(void* const* d_in, const int* in_sizes, int n_in, void* d_out, int out_size, void* d_ws, size_t ws_size, hipStream_t stream) {
    static int grid = 0;
    if (grid == 0) {
        if (n_in != 19 || ws_size < WS_END) { fprintf(stderr, "kernel_launch: unexpected n_in %d / ws_size %zu (need %zu)\n", n_in, ws_size, (size_t)WS_END); grid = -1; return; }
        int dev = 0, cus = 0, per_cu = 0;
        hipGetDevice(&dev); hipDeviceGetAttribute(&cus, hipDeviceAttributeMultiprocessorCount, dev);
        if (hipFuncSetAttribute((const void*)fwd_mega, hipFuncAttributeMaxDynamicSharedMemorySize, LDS_BYTES) != hipSuccess) { fprintf(stderr, "kernel_launch: hipFuncSetAttribute failed\n"); grid = -1; return; }
        if (hipOccupancyMaxActiveBlocksPerMultiprocessor(&per_cu, (const void*)fwd_mega, 512, LDS_BYTES) != hipSuccess || per_cu < 1) { fprintf(stderr, "kernel_launch: occupancy query says %d\n", per_cu); per_cu = 1; }
        (void)hipGetLastError();
        grid = cus * 1;
    }
    if (grid < 0) return;
    if (hipMemsetAsync((char*)d_ws + WS_CTL, 0, 65536, stream) != hipSuccess) { fprintf(stderr, "kernel_launch: memset failed\n"); return; }
    Args a{};
    for (int i = 0; i < 19; ++i) a.in[i] = (const float*)d_in[i];
    a.out = (float*)d_out; a.ws = (unsigned char*)d_ws;
    void* kargs[] = {&a};
    hipError_t e = hipLaunchCooperativeKernel((const void*)fwd_mega, dim3(grid), dim3(512), kargs, LDS_BYTES, stream);
    if (e != hipSuccess) fprintf(stderr, "cooperative launch failed: %s (grid %d)\n", hipGetErrorString(e), grid);
}
```

```cpp
#ifndef PH
#define PH 127
#endif
#include <hip/hip_runtime.h>
#include <hip/hip_cooperative_groups.h>
#include <cstdio>
#include <cstdint>
namespace cg = cooperative_groups;

#define LAS __attribute__((address_space(3)))
#define PG8_LAS LAS
typedef unsigned short bf16_t;
typedef short bf16x8 __attribute__((ext_vector_type(8)));
typedef float f32x4 __attribute__((ext_vector_type(4)));
typedef float f32x16 __attribute__((ext_vector_type(16)));
typedef unsigned u32x4 __attribute__((ext_vector_type(4)));
typedef unsigned u32x2 __attribute__((ext_vector_type(2)));

constexpr int DM = 1024, NB = 16, SEQ = 2048, DEPTH = 4, SB = 32, SS = 16;
constexpr int NP = NB * SEQ, NS = SB * SS, M = NP + NS, MP = 33792;
constexpr int PW = 2560, PROJ = 3072, DFF = 2816, UPW = 5632, LDV = MP;
constexpr float EPS = 1e-6f, LOG2E = 1.4426950408889634f;
constexpr size_t O_Y = 0;
constexpr size_t O_KP = (size_t)M * DM;
constexpr size_t O_VP = O_KP + (size_t)DEPTH * NB * 512 * 512;
constexpr size_t O_CP = O_VP + (size_t)DEPTH * NB * 512 * 512;
constexpr size_t O_FP = O_CP + (size_t)DEPTH * NB * 2 * 512;
constexpr size_t O_KS = O_FP + (size_t)DEPTH * NB * 2 * UPW;
constexpr size_t O_VS = O_KS + (size_t)DEPTH * SB * SS * 512;
constexpr size_t O_CS = O_VS + (size_t)DEPTH * SB * SS * 512;
constexpr size_t O_FS = O_CS + (size_t)DEPTH * SB * 2 * 512;
constexpr size_t MiB = 1u << 20;
constexpr size_t WS_CTL = 0;
constexpr size_t WS_W = 1 * MiB;
constexpr size_t W_IN = 0, W_OUT = 6 * MiB, W_UP = 8 * MiB, W_DOWN = 19 * MiB, W_LAYER = 25 * MiB;
constexpr size_t WS_XG = WS_W + 4 * W_LAYER;
constexpr size_t WS_SSQ = WS_XG + 66 * MiB;
constexpr size_t WS_P5 = WS_SSQ + 3 * MiB;
constexpr size_t WS_VT = WS_P5 + 165 * MiB;
constexpr size_t WS_ACT = WS_P5;
constexpr size_t WS_MIX = WS_VT + 33 * MiB;
constexpr size_t WS_KC = WS_MIX + 66 * MiB;
constexpr size_t WS_VCT = WS_KC + 16 * MiB;
constexpr size_t WS_FIRST = WS_VCT + 16 * MiB;
constexpr size_t WS_LAST = WS_FIRST + 6 * MiB;
constexpr size_t WS_KF = WS_LAST + 6 * MiB;
constexpr size_t WS_PART = WS_KF + 34 * MiB;
constexpr size_t WS_END = WS_PART + 22 * MiB;
static_assert((size_t)MP * 2816 * 2 <= (size_t)198 * MiB, "ACT overlay");
constexpr int LDS_BYTES = 156160, EXTRA_OFF = 131072;
constexpr int X_PRE = 8448, X_W = 16640, X_BAR = 24832;

__device__ __forceinline__ unsigned cvt_pk_bf16(float lo, float hi) { unsigned r; asm volatile("v_cvt_pk_bf16_f32 %0, %1, %2" : "=v"(r) : "v"(lo), "v"(hi)); return r; }
__device__ __forceinline__ float bf2f(unsigned short b) { return __builtin_bit_cast(float, (unsigned)b << 16); }
__device__ __forceinline__ float rstd_of(f32x4 p) { return rsqrtf(((p.x + p.y) + (p.z + p.w)) * (1.0f / 1024.0f) + EPS); }
template <int CTRL> __device__ __forceinline__ float dppf(float old, float src) {
    return __builtin_bit_cast(float, __builtin_amdgcn_update_dpp(__builtin_bit_cast(int, old), __builtin_bit_cast(int, src), CTRL, 0xf, 0xf, false));
}

typedef const __attribute__((address_space(4))) char* kargp_t;
__device__ __forceinline__ const float* karg(int k) { kargp_t p = (kargp_t)__builtin_amdgcn_kernarg_segment_ptr(); asm volatile("" : "+s"(p)); return *(const float* const __attribute__((address_space(4)))*)(p + 8 * k); }
namespace pg8 {
constexpr int BM = 256, BK = 64, HALF = 128, HTB = HALF * BK * 2, STAGE_BYTES = 8 * HTB, NXCD = 8, WGM = 4;
__host__ __device__ __forceinline__ int lds_byte(int r, int c) { const int st = (r >> 4) * 2 + (c >> 5), rr = r & 15, cc = c & 31, ob = rr * 64 + cc * 2; return st * 1024 + (ob ^ (((ob >> 9) & 1) << 5)); }
__host__ __device__ __forceinline__ void stage_rc(int b, int& R, int& C) { const int st = b / 1024, sb = b % 1024, swz = sb ^ (((sb >> 9) & 1) << 5); R = (st >> 1) * 16 + swz / 64; C = (st & 1) * 32 + (swz % 64) / 2; }
__host__ __device__ __forceinline__ int perm32(int rho) { const int n = rho >> 4, i = rho & 15; return 8 * (i >> 2) + 4 * n + (i & 3); }
struct Unit { int pm, pn, kind, nt; int slice, nsplit, tile, pad; const char* a; const char* b; };
__device__ __forceinline__ void map_tile(int L, int nM, int nN, int& pm, int& pn) {
    const int nwg = nM * nN; int wgid = L;
    { const int q = nwg / NXCD, r = nwg % NXCD, xcd = wgid % NXCD, off = wgid / NXCD; wgid = (xcd < r ? xcd * (q + 1) : r * (q + 1) + (xcd - r) * q) + off; }
    const int nig = WGM * nN, gid = wgid / nig, fm = gid * WGM, gsz = (nM - fm) < WGM ? (nM - fm) : WGM;
    pm = fm + ((wgid % nig) % gsz); pn = (wgid % nig) / gsz;
}
template <class Epi, class Sched, bool ALIGN_EPI = false, bool SP2 = false>
__device__ __forceinline__ void gemm_phase(PG8_LAS unsigned char* lds, const int Kdim, const Sched& S, const Epi& E) {
    int tid_o = threadIdx.x; asm volatile("" : "+v"(tid_o));
    const int tid = tid_o, wid = __builtin_amdgcn_readfirstlane(tid >> 6), lane = tid & 63, wr = wid >> 2, wc = wid & 3, fr = lane & 15, fq = lane >> 4;
    const int K = Kdim;
    unsigned voffA[2], voffB[2]; int aoff, boff;
#define PG8_ADDR_SETUP(t_) do { _Pragma("unroll") for (int i = 0; i < 2; ++i) { int R, C; stage_rc((t_) * 16 + i * 8192, R, C); const int Rb = Epi::PERM ? ((R & ~31) + perm32(R & 31)) : R; \
        voffA[i] = (unsigned)(R * K + C) * 2u; voffB[i] = (unsigned)(Rb * K + C) * 2u; } \
        aoff = lds_byte(wr * 64 + ((t_) & 15), (((t_) & 63) >> 4) * 8); boff = lds_byte(wc * 32 + ((t_) & 15), (((t_) & 63) >> 4) * 8); } while (0)
    PG8_ADDR_SETUP(tid);
    const size_t kstep = (size_t)(BK * 2);
    const size_t hstep = (size_t)HALF * K * 2;
    const size_t tstep = 2 * hstep;
    const unsigned ldsw = (unsigned)wid * 1024u;
#define PG8_SA(b, h) (((b) * 2 + (h)) * HTB)
#define PG8_SB(b, h) ((4 + (b) * 2 + (h)) * HTB)
#define PG8_STAGE(bufoff, gbase, voff) do { _Pragma("unroll") for (int _i = 0; _i < 2; ++_i) \
        __builtin_amdgcn_global_load_lds((const unsigned*)((const char*)(gbase) + (voff)[_i]), (PG8_LAS unsigned*)(lds + (bufoff) + ldsw + _i * 8192), 16, 0, 0); } while (0)
#define PG8_LDA(dst, b, h) do { _Pragma("unroll") for (int m = 0; m < 4; ++m) _Pragma("unroll") for (int k = 0; k < 2; ++k) dst[m][k] = *(const PG8_LAS bf16x8*)(lds + PG8_SA(b, h) + aoff + m * 2048 + k * 1024); } while (0)
#define PG8_LDB(dst, b, h) do { _Pragma("unroll") for (int n = 0; n < 2; ++n) _Pragma("unroll") for (int k = 0; k < 2; ++k) dst[n][k] = *(const PG8_LAS bf16x8*)(lds + PG8_SB(b, h) + boff + n * 2048 + k * 1024); } while (0)
#define PG8_MMA(ai, bj, At, Bt) do { __builtin_amdgcn_s_setprio(1); _Pragma("unroll") for (int m = 0; m < 4; ++m) _Pragma("unroll") for (int n = 0; n < 2; ++n) _Pragma("unroll") for (int k = 0; k < 2; ++k) \
        acc[ai][bj][m][n] = __builtin_amdgcn_mfma_f32_16x16x32_bf16(Bt[n][k], At[m][k], acc[ai][bj][m][n], 0, 0, 0); __builtin_amdgcn_s_setprio(0); } while (0)
#define PG8_WAIT_V(n) asm volatile("s_waitcnt vmcnt(" #n ")" ::: "memory")
#define PG8_WAIT_L(n) asm volatile("s_waitcnt lgkmcnt(" #n ")" ::: "memory")
#define PG8_BAR __builtin_amdgcn_s_barrier()
#define PG8_SCHED __builtin_amdgcn_sched_barrier(0)
    Unit cur, nxt; int ui = 0;
    if (!S.next(0, cur)) return;
    E.pre_issue(cur, 0, wid, lane, lds);
    f32x4 acc[2][2][4][2];
#pragma unroll
    for (int a = 0; a < 2; ++a)
#pragma unroll
        for (int b = 0; b < 2; ++b)
#pragma unroll
            for (int m = 0; m < 4; ++m)
#pragma unroll
                for (int n = 0; n < 2; ++n) acc[a][b][m][n] = (f32x4){0.f, 0.f, 0.f, 0.f};
    bf16x8 At[4][2], B0[2][2], B1[2][2];
    const char* cA = cur.a; const char* cB = cur.b;

    if constexpr (SP2) {
        PG8_STAGE(PG8_SB(0, 0), cB, voffB); PG8_STAGE(PG8_SB(0, 1), cB + hstep, voffB); PG8_STAGE(PG8_SA(0, 0), cA, voffA); PG8_STAGE(PG8_SA(0, 1), cA + hstep, voffA);
        if (wr == 1) PG8_BAR;
        PG8_WAIT_V(2); PG8_BAR;
        PG8_STAGE(PG8_SB(1, 0), cB + kstep, voffB); PG8_STAGE(PG8_SA(1, 0), cA + kstep, voffA); PG8_STAGE(PG8_SB(1, 1), cB + hstep + kstep, voffB);
        PG8_WAIT_V(6); PG8_BAR;
    } else {
        PG8_STAGE(PG8_SB(0, 0), cB, voffB); PG8_STAGE(PG8_SA(0, 0), cA, voffA); PG8_STAGE(PG8_SB(0, 1), cB + hstep, voffB); PG8_STAGE(PG8_SA(0, 1), cA + hstep, voffA);
        if (wr == 1) PG8_BAR;
        PG8_WAIT_V(4); PG8_BAR;
        PG8_STAGE(PG8_SB(1, 0), cB + kstep, voffB); PG8_STAGE(PG8_SA(1, 0), cA + kstep, voffA); PG8_STAGE(PG8_SB(1, 1), cB + hstep + kstep, voffB);
        PG8_WAIT_V(6); PG8_BAR;
    }
    for (;;) {
        const bool has_next = S.next(ui + 1, nxt);
        const char* nA = has_next ? nxt.a : cA; const char* nB = has_next ? nxt.b : cB;
        const int nt = cur.nt;
        for (int t = 0; t < nt; t += 2) {
            const bool last = (t == nt - 2);
            const char* a1 = cA + (size_t)(t + 1) * kstep;
            const char* a2 = last ? nA : cA + (size_t)(t + 2) * kstep; const char* b2 = last ? nB : cB + (size_t)(t + 2) * kstep;
            const char* a3 = a2 + kstep; const char* b3 = b2 + kstep;

            if constexpr (SP2) {
            PG8_LDB(B0, 0, 0); PG8_LDB(B1, 0, 1); PG8_SCHED; PG8_LDA(At, 0, 0); PG8_STAGE(PG8_SA(1, 1), a1 + hstep, voffA);
            PG8_WAIT_V(8); PG8_WAIT_L(0); PG8_BAR; PG8_MMA(0, 0, At, B0); PG8_MMA(0, 1, At, B1); PG8_BAR; PG8_SCHED;
            PG8_LDA(At, 0, 1); PG8_STAGE(PG8_SB(0, 0), b2, voffB); PG8_STAGE(PG8_SB(0, 1), b2 + hstep, voffB); PG8_STAGE(PG8_SA(0, 0), a2, voffA);
            PG8_WAIT_V(8); PG8_WAIT_L(0); PG8_BAR; PG8_MMA(1, 0, At, B0); PG8_MMA(1, 1, At, B1); PG8_BAR; PG8_SCHED;
            PG8_LDB(B0, 1, 0); PG8_LDB(B1, 1, 1); PG8_SCHED; PG8_LDA(At, 1, 0); PG8_STAGE(PG8_SA(0, 1), a2 + hstep, voffA);
            PG8_WAIT_V(8); PG8_WAIT_L(0); PG8_BAR; PG8_MMA(0, 0, At, B0); PG8_MMA(0, 1, At, B1); PG8_BAR; PG8_SCHED;
            PG8_LDA(At, 1, 1); PG8_STAGE(PG8_SB(1, 0), b3, voffB); PG8_STAGE(PG8_SB(1, 1), b3 + hstep, voffB); PG8_STAGE(PG8_SA(1, 0), a3, voffA);
            PG8_WAIT_V(8); PG8_WAIT_L(0); PG8_BAR; PG8_MMA(1, 0, At, B0); PG8_MMA(1, 1, At, B1); PG8_BAR; PG8_SCHED;
            } else {
            PG8_LDB(B0, 0, 0); PG8_SCHED; PG8_LDA(At, 0, 0); PG8_STAGE(PG8_SA(1, 1), a1 + hstep, voffA);
            PG8_WAIT_L(8); PG8_BAR; PG8_WAIT_L(0); PG8_MMA(0, 0, At, B0); PG8_BAR; PG8_SCHED;
            PG8_LDB(B1, 0, 1); PG8_STAGE(PG8_SB(0, 0), b2, voffB);
            PG8_BAR; PG8_WAIT_L(0); PG8_MMA(0, 1, At, B1); PG8_BAR;
            PG8_LDA(At, 0, 1); PG8_STAGE(PG8_SA(0, 0), a2, voffA);
            PG8_BAR; PG8_WAIT_L(0); PG8_MMA(1, 0, At, B0); PG8_BAR; PG8_SCHED;
            PG8_STAGE(PG8_SB(0, 1), b2 + hstep, voffB);
            PG8_WAIT_V(6); PG8_BAR; PG8_MMA(1, 1, At, B1); PG8_BAR;
            PG8_LDB(B0, 1, 0); PG8_SCHED; PG8_LDA(At, 1, 0); PG8_STAGE(PG8_SA(0, 1), a2 + hstep, voffA);
            PG8_WAIT_L(8); PG8_BAR; PG8_WAIT_L(0); PG8_MMA(0, 0, At, B0); PG8_BAR; PG8_SCHED;
            PG8_LDB(B1, 1, 1); PG8_STAGE(PG8_SB(1, 0), b3, voffB);
            PG8_BAR; PG8_WAIT_L(0); PG8_MMA(0, 1, At, B1); PG8_BAR;
            PG8_LDA(At, 1, 1); PG8_STAGE(PG8_SA(1, 0), a3, voffA);
            PG8_BAR; PG8_WAIT_L(0); PG8_MMA(1, 0, At, B0); PG8_BAR; PG8_SCHED;
            PG8_STAGE(PG8_SB(1, 1), b3 + hstep, voffB);
            PG8_WAIT_V(6); PG8_BAR; PG8_MMA(1, 1, At, B1); PG8_BAR;
            }
        }
        if constexpr (ALIGN_EPI) { if (wr == 0) PG8_BAR; }
        bool do_epi = true;
        if (cur.nsplit > 1) {
            float* part = (float*)((unsigned char*)karg(20) + WS_PART);
            unsigned* cnt = (unsigned*)((unsigned char*)karg(20) + WS_CTL + 32768) + S.cbase + cur.tile;
            f32x4* mine = (f32x4*)(part + ((size_t)cur.tile * 2 + cur.slice) * 65536) + tid;
#pragma unroll
            for (int a = 0; a < 2; ++a)
#pragma unroll
                for (int b = 0; b < 2; ++b)
#pragma unroll
                    for (int m = 0; m < 4; ++m) {
#pragma unroll
                        for (int n = 0; n < 2; ++n) { f32x4* p_ = mine + (((a * 2 + b) * 4 + m) * 2 + n) * 512; asm volatile("global_store_dwordx4 %0, %1, off sc1\n\ts_nop 1" :: "v"(p_), "v"(acc[a][b][m][n]) : "memory"); }
                        __builtin_amdgcn_sched_barrier(0);
                    }
            asm volatile("s_waitcnt vmcnt(0)" ::: "memory");
            PG8_BAR;
            LAS unsigned* flag = (LAS unsigned*)(lds + EXTRA_OFF + 8192 + 64);
            if (tid == 0) {
                const unsigned old = __hip_atomic_fetch_add(cnt, 1u, __ATOMIC_RELAXED, __HIP_MEMORY_SCOPE_AGENT);
                if (old == 1u) { __builtin_amdgcn_fence(__ATOMIC_ACQUIRE, "agent"); asm volatile("s_waitcnt vmcnt(0)" ::: "memory"); }
                *flag = old;
            }
            asm volatile("s_waitcnt lgkmcnt(0)" ::: "memory");
            PG8_BAR;
            const unsigned old = *flag;
            asm volatile("s_waitcnt lgkmcnt(0)" ::: "memory");
            PG8_BAR;
            do_epi = (old == 1u);
            if (do_epi) {
                const f32x4* oth = (const f32x4*)(part + ((size_t)cur.tile * 2 + (cur.slice ^ 1)) * 65536) + tid;
#pragma unroll
                for (int a = 0; a < 2; ++a)
#pragma unroll
                    for (int b = 0; b < 2; ++b) {
#pragma unroll
                        for (int m = 0; m < 4; ++m)
#pragma unroll
                            for (int n = 0; n < 2; ++n) acc[a][b][m][n] += oth[(((a * 2 + b) * 4 + m) * 2 + n) * 512];
                        __builtin_amdgcn_sched_barrier(0);
                    }
            }
        }
        if (do_epi) E(acc, cur, ui, wr, wc, fr, fq, lane, lds);
        if (!has_next) break;
#pragma unroll
        for (int a = 0; a < 2; ++a)
#pragma unroll
            for (int b = 0; b < 2; ++b)
#pragma unroll
                for (int m = 0; m < 4; ++m)
#pragma unroll
                    for (int n = 0; n < 2; ++n) acc[a][b][m][n] = (f32x4){0.f, 0.f, 0.f, 0.f};
        cur = nxt; cA = nA; cB = nB; ++ui;
        asm volatile("s_waitcnt lgkmcnt(0)" ::: "memory"); E.pre_issue(cur, ui, wid, lane, lds);
        { int t2 = threadIdx.x; asm volatile("" : "+v"(t2)); PG8_ADDR_SETUP(t2); }
        if constexpr (ALIGN_EPI) { if (wr == 1) PG8_BAR; }
    }
    PG8_WAIT_V(0);
    if constexpr (!ALIGN_EPI) { if (wr == 0) PG8_BAR; }
    PG8_BAR;

#undef PG8_ADDR_SETUP
#undef PG8_SA
#undef PG8_SB
#undef PG8_STAGE
#undef PG8_LDA
#undef PG8_LDB
#undef PG8_MMA
#undef PG8_WAIT_V
#undef PG8_WAIT_L
#undef PG8_BAR
#undef PG8_SCHED
}
}
using pg8::Unit;
__device__ __forceinline__ void pre_rows(const float* ssq4, int rowbase, int ui, int wid, int lane, LAS unsigned char* lds) {
    LAS unsigned* dst = (LAS unsigned*)(lds + EXTRA_OFF + X_PRE) + (ui & 1) * 1024 + wid * 128;
    const float* src = ssq4 + ((ptrdiff_t)rowbase + wid * 32) * 4 + lane;
    __builtin_amdgcn_global_load_lds((const unsigned*)src, dst, 4, 0, 0);
    __builtin_amdgcn_global_load_lds((const unsigned*)(src + 64), dst + 64, 4, 0, 0);
}
constexpr size_t TSTEP1K = (size_t)256 * 1024 * 2;
struct SchedGemm {
    const char* A; const char* Bt; int nN, G, c, nt, S, cbase; size_t tstep;
    __device__ __forceinline__ bool next(int i, Unit& u) const {
        long L = (long)i * G + c; const int npr = 128 * nN;
        u.kind = 0; u.pad = 0;
        if (L < npr) { pg8::map_tile((int)L, 128, nN, u.pm, u.pn); u.nt = nt; u.slice = 0; u.nsplit = 1; u.tile = 0; u.a = A + (size_t)u.pm * tstep; u.b = Bt + (size_t)u.pn * tstep; return true; }
        L -= npr; if (L >= 2 * nN * S) return false;
        const int tile = (int)(L / S), sl = (int)(L % S), nts = nt / S;
        u.pm = 128 + (tile & 1); u.pn = tile >> 1; u.nt = nts; u.slice = sl; u.nsplit = S; u.tile = tile;
        u.a = A + (size_t)u.pm * tstep + (size_t)sl * nts * 128; u.b = Bt + (size_t)u.pn * tstep + (size_t)sl * nts * 128; return true;
    }
};
struct SchedIn {
    const char* XG; const char* Wmain; const char* Wv; int G, c, cbase;
    __device__ __forceinline__ bool next(int i, Unit& u) const {
        long L = (long)i * G + c;
        u.pad = 0; u.nt = 16; u.slice = 0; u.nsplit = 1; u.tile = 0;
        if (L < 1280) { pg8::map_tile((int)L, 128, 10, u.pm, u.pn); u.kind = 0; u.a = XG + (size_t)u.pm * TSTEP1K; u.b = Wmain + (size_t)u.pn * TSTEP1K; return true; }
        L -= 1280;
        if (L < 256) { u.pm = (int)(L & 1); u.pn = (int)(L >> 1); u.kind = 1; u.a = Wv + (size_t)u.pm * TSTEP1K; u.b = XG + (size_t)u.pn * TSTEP1K; return true; }
        L -= 256; if (L >= 24) return false;
        const int tile = (int)L;
        if (tile < 20) { u.pm = 128 + (tile & 1); u.pn = tile >> 1; u.kind = 0; u.a = XG + (size_t)u.pm * TSTEP1K; u.b = Wmain + (size_t)u.pn * TSTEP1K; }
        else { const int tt = tile - 20; u.pm = tt & 1; u.pn = 128 + (tt >> 1); u.kind = 1; u.a = Wv + (size_t)u.pm * TSTEP1K; u.b = XG + (size_t)u.pn * TSTEP1K; }
        return true;
    }
};

struct SchedUp {
    const char* A; const char* Bt; int G, c, cbase;
    __device__ __forceinline__ bool next(int i, Unit& u) const {
        long L = (long)i * G + c;
        u.kind = 0; u.nt = 16; u.slice = 0; u.nsplit = 1; u.tile = 0;
        if (L < 130 * 22) { pg8::map_tile((int)L, 130, 22, u.pm, u.pn); u.pad = 254 * u.pm - 2; }
        else { L -= 130 * 22; if (L >= 44) return false; u.pm = 130 + (int)(L & 1); u.pn = (int)(L >> 1); u.pad = NP + 256 * (int)(L & 1); }
        u.a = A + (ptrdiff_t)u.pad * 2048; u.b = Bt + (size_t)u.pn * TSTEP1K; return true;
    }
};

struct EpiIn {
    static constexpr bool PERM = true, AFTER_DRAIN = false;
    int l;
    __device__ __forceinline__ void pre_issue(const Unit& u, int ui, int wid, int lane, LAS unsigned char* lds) const {
        pre_rows((const float*)((unsigned char*)karg(20) + WS_SSQ), 256 * (u.kind == 0 ? u.pm : u.pn), ui, wid, lane, lds);
    }
    __device__ __forceinline__ void operator()(f32x4 (&acc)[2][2][4][2], const Unit& u, int ui, int wr, int wc, int fr, int fq, int lane, LAS unsigned char* lds) const {
        asm volatile("" : "+v"(fr), "+v"(fq), "+v"(lane));
        unsigned char* wsb = (unsigned char*)karg(20); float* outb = (float*)karg(19);
        const LAS f32x4* pre = (const LAS f32x4*)(lds + EXTRA_OFF + X_PRE) + (ui & 1) * 256; bf16_t* P5 = (bf16_t*)(wsb + WS_P5); bf16_t* VT = (bf16_t*)(wsb + WS_VT); bf16_t* KF = (bf16_t*)(wsb + WS_KF);
        float* okp = outb + O_KP + (size_t)l * NB * 512 * 512; float* ovp = outb + O_VP + (size_t)l * NB * 512 * 512;
        float* oks = outb + O_KS + (size_t)l * SB * SS * 512; float* ovs = outb + O_VS + (size_t)l * SB * SS * 512;
        asm volatile("s_waitcnt lgkmcnt(0)" ::: "memory"); __builtin_amdgcn_s_barrier(); asm volatile("" ::: "memory");
        if (u.kind == 0) {
            const int rbase = u.pm * 256 + wr * 64;
            const float st0 = rstd_of(pre[64 * wr + lane]), st1 = rstd_of(pre[128 + 64 * wr + lane]);
            const bool samp = u.pm >= 128;
            const bool kout = (u.pn == 2 || u.pn == 3) && (samp || (u.pm & 7) >= 6);
#pragma unroll
            for (int ai = 0; ai < 2; ++ai)
#pragma unroll
                for (int m = 0; m < 4; ++m) {
                    const float rs = __shfl(ai ? st1 : st0, 16 * m + fr);
                    const int row = rbase + 128 * ai + 16 * m + fr;
                    if (u.pn >= 6) {
                        const f32x4 p0 = (acc[ai][0][m][0] * rs) * (acc[ai][1][m][0] * rs), p1 = (acc[ai][0][m][1] * rs) * (acc[ai][1][m][1] * rs);
                        u32x4 w; w.x = cvt_pk_bf16(p0[0], p0[1]); w.y = cvt_pk_bf16(p0[2], p0[3]); w.z = cvt_pk_bf16(p1[0], p1[1]); w.w = cvt_pk_bf16(p1[2], p1[3]);
                        *(u32x4*)(P5 + (unsigned)(row * PW + 1536 + (u.pn - 6) * 128 + wc * 32 + 8 * fq)) = w;
                    } else
#pragma unroll
                    for (int bj = 0; bj < 2; ++bj) {
                        const f32x4 v0 = acc[ai][bj][m][0] * rs, v1 = acc[ai][bj][m][1] * rs;
                        const int col0 = u.pn * 256 + bj * 128 + wc * 32 + 8 * fq;
                        u32x4 w; w.x = cvt_pk_bf16(v0[0], v0[1]); w.y = cvt_pk_bf16(v0[2], v0[3]); w.z = cvt_pk_bf16(v1[0], v1[1]); w.w = cvt_pk_bf16(v1[2], v1[3]);
                        if (u.pn == 2 || u.pn == 3) {
                            const unsigned c = (unsigned)(col0 - 512), hh = c >> 6, d0 = c & 63;
                            *(u32x4*)(KF + (unsigned)((((((unsigned)row >> 5) * 8 + hh) * 4 + (d0 >> 4)) * 32 + ((unsigned)row & 31)) * 16 + (d0 & 15))) = w;
                        } else
                        *(u32x4*)(P5 + (unsigned)(row * PW + col0)) = w;
                        if (kout) {
                            const unsigned ridx = samp ? (unsigned)(row - NP) : (unsigned)((u.pm >> 3) * 512 + (row & 2047) - 1536);
                            float* o = (samp ? oks : okp) + (unsigned)(ridx * 512 + (col0 - 512));
                            *(f32x4*)o = v0; *(f32x4*)(o + 4) = v1;
                        }
                    }
                    __builtin_amdgcn_sched_barrier(0);
                }
        } else {
            const int tok0 = u.pn * 256 + wc * 32;
            const float st = rstd_of(pre[32 * wc + 128 * (lane >> 5) + (lane & 31)]);
            float cs[2][2][4];
#pragma unroll
            for (int bj = 0; bj < 2; ++bj)
#pragma unroll
                for (int n = 0; n < 2; ++n)
#pragma unroll
                    for (int j = 0; j < 4; ++j) cs[bj][n][j] = __shfl(st, 32 * bj + 8 * fq + 4 * n + j);
            const bool samp = u.pn >= 128; const bool vout = samp || (u.pn & 7) >= 6;
#pragma unroll
            for (int ai = 0; ai < 2; ++ai)
#pragma unroll
                for (int m = 0; m < 4; ++m) {
                    const int ch = u.pm * 256 + 128 * ai + 64 * wr + 16 * m + fr;
#pragma unroll
                    for (int bj = 0; bj < 2; ++bj) {
                        f32x4 v0 = acc[ai][bj][m][0], v1 = acc[ai][bj][m][1];
#pragma unroll
                        for (int j = 0; j < 4; ++j) { v0[j] *= cs[bj][0][j]; v1[j] *= cs[bj][1][j]; }
                        const int tokc = u.pn * 256 + bj * 128 + wc * 32 + 8 * fq;
                        { u32x2 w0, w1; w0.x = cvt_pk_bf16(v0[0], v0[1]); w0.y = cvt_pk_bf16(v0[2], v0[3]); w1.x = cvt_pk_bf16(v1[0], v1[1]); w1.y = cvt_pk_bf16(v1[2], v1[3]);
                          const unsigned vb = (((unsigned)tokc >> 4) * 512 + (unsigned)ch) * 16 + 4 * (((unsigned)tokc >> 3) & 1);
                          *(u32x2*)(VT + vb) = w0; *(u32x2*)(VT + vb + 8) = w1; }
                        if (vout) {
                            const unsigned ridx = samp ? (unsigned)(tokc - NP) : (unsigned)((u.pn >> 3) * 512 + (tokc & 2047) - 1536);
                            float* ob = samp ? ovs : ovp; const unsigned oi = ridx * 512 + ch;
#pragma unroll
                            for (int j = 0; j < 4; ++j) { ob[oi + j * 512] = v0[j]; ob[oi + (4 + j) * 512] = v1[j]; }
                        }
                    }
                    __builtin_amdgcn_sched_barrier(0);
                }
        }
    }
};

struct EpiRes {
    static constexpr bool PERM = true, AFTER_DRAIN = false;
    bf16_t* XG; float* ssq4;
    __device__ __forceinline__ void pre_issue(const Unit&, int, int, int, LAS unsigned char*) const {}
    __device__ __forceinline__ void operator()(f32x4 (&acc)[2][2][4][2], const Unit& u, int ui, int wr, int wc, int fr, int fq, int lane, LAS unsigned char* lds) const {
        asm volatile("" : "+v"(fr), "+v"(fq), "+v"(lane));
        const unsigned cbase = (unsigned)(u.pn * 256 + wc * 32 + 8 * fq), rb = (unsigned)(u.pm * 256 + 64 * wr + fr);
        LAS float* red = (LAS float*)(lds + EXTRA_OFF);
        u32x4 xin[2][2];
#define EPR_LOAD(IT, BUF) do { const unsigned row_ = rb + 128 * ((IT) >> 2) + 16 * ((IT) & 3); _Pragma("unroll") for (int bj = 0; bj < 2; ++bj) \
            xin[BUF][bj] = *(const u32x4*)(XG + (row_ * DM + cbase + bj * 128)); } while (0)
        EPR_LOAD(0, 0);
#pragma unroll
        for (int it = 0; it < 8; ++it) {
            if (it + 1 < 8) EPR_LOAD(it + 1, (it + 1) & 1);
            __builtin_amdgcn_sched_barrier(0);
            const int ai = it >> 2, m = it & 3;
            const unsigned row = rb + 128 * ai + 16 * m;
            float ss = 0.f;
#pragma unroll
            for (int bj = 0; bj < 2; ++bj) {
                const u32x4 xw = xin[it & 1][bj];
                f32x4 v0, v1;
                v0[0] = __builtin_bit_cast(float, xw.x << 16); v0[1] = __builtin_bit_cast(float, xw.x & 0xffff0000u); v0[2] = __builtin_bit_cast(float, xw.y << 16); v0[3] = __builtin_bit_cast(float, xw.y & 0xffff0000u);
                v1[0] = __builtin_bit_cast(float, xw.z << 16); v1[1] = __builtin_bit_cast(float, xw.z & 0xffff0000u); v1[2] = __builtin_bit_cast(float, xw.w << 16); v1[3] = __builtin_bit_cast(float, xw.w & 0xffff0000u);
                v0 += acc[ai][bj][m][0]; v1 += acc[ai][bj][m][1];
                ss += ((v0[0] * v0[0] + v0[1] * v0[1]) + (v0[2] * v0[2] + v0[3] * v0[3])) + ((v1[0] * v1[0] + v1[1] * v1[1]) + (v1[2] * v1[2] + v1[3] * v1[3]));
                u32x4 w; w.x = cvt_pk_bf16(v0[0], v0[1]); w.y = cvt_pk_bf16(v0[2], v0[3]); w.z = cvt_pk_bf16(v1[0], v1[1]); w.w = cvt_pk_bf16(v1[2], v1[3]);
                *(u32x4*)(XG + (row * DM + cbase + bj * 128)) = w;
            }
            ss += __shfl_xor(ss, 16); ss += __shfl_xor(ss, 32);
            if (fq == 0) red[(128 * ai + 64 * wr + 16 * m + fr) * 4 + wc] = ss;
            __builtin_amdgcn_sched_barrier(0);
        }
#undef EPR_LOAD
        asm volatile("s_waitcnt lgkmcnt(0)" ::: "memory"); __builtin_amdgcn_s_barrier(); asm volatile("" ::: "memory");
        { const int t_ = (wr * 4 + wc) * 64 + lane; if (t_ < 256) { const f32x4 p = *(const LAS f32x4*)(red + 4 * t_); ssq4[(unsigned)((u.pm * 256 + t_) * 4 + u.pn)] = (p.x + p.y) + (p.z + p.w); } }
    }
};

struct EpiUp {
    static constexpr bool PERM = true, AFTER_DRAIN = false;
    int l;
    __device__ __forceinline__ void pre_issue(const Unit& u, int ui, int wid, int lane, LAS unsigned char* lds) const {
        pre_rows((const float*)((unsigned char*)karg(20) + WS_SSQ) + (1u << 18), u.pad, ui, wid, lane, lds);
        const int arr = wid >> 1, hf = wid & 1;
        const float* src = (arr < 3 ? karg(15) + (size_t)l * 3 * UPW + (size_t)arr * UPW : karg(16) + (size_t)l * UPW) + hf * DFF + u.pn * 128 + lane;
        LAS unsigned* wd = (LAS unsigned*)(lds + EXTRA_OFF + X_W) + (ui & 1) * 1024 + arr * 256 + hf * 128;
        __builtin_amdgcn_global_load_lds((const unsigned*)src, wd, 4, 0, 0);
        __builtin_amdgcn_global_load_lds((const unsigned*)(src + 64), wd + 64, 4, 0, 0);
    }
    __device__ __forceinline__ void operator()(f32x4 (&acc)[2][2][4][2], const Unit& u, int ui, int wr, int wc, int fr, int fq, int lane, LAS unsigned char* lds) const {
        asm volatile("" : "+v"(fr), "+v"(fq), "+v"(lane));
        unsigned char* wsb = (unsigned char*)karg(20); float* outb = (float*)karg(19);
        const LAS f32x4* pre = (const LAS f32x4*)(lds + EXTRA_OFF + X_PRE) + (ui & 1) * 256; (void)wsb;
        float* offs = outb + O_FS + (size_t)l * SB * 2 * UPW;
        const int rbase = u.pad + wr * 64;
        const bool samp = u.pm >= 130;
        asm volatile("s_waitcnt lgkmcnt(0)" ::: "memory"); __builtin_amdgcn_s_barrier(); asm volatile("" ::: "memory");
        const float st0 = rstd_of(pre[64 * wr + lane]), st1 = rstd_of(pre[128 + 64 * wr + lane]);
        LAS float* halo = (LAS float*)(lds + EXTRA_OFF);
        const int ccol = wc * 32 + 8 * fq;
#pragma unroll
        for (int ai = 0; ai < 2; ++ai)
#pragma unroll
            for (int m = 0; m < 4; ++m) {
                const float rs = __shfl(ai ? st1 : st0, 16 * m + fr);
#pragma unroll
                for (int bj = 0; bj < 2; ++bj)
#pragma unroll
                    for (int n = 0; n < 2; ++n) acc[ai][bj][m][n] *= rs;
            }
        if (fr >= 14) {
#pragma unroll
            for (int ai = 0; ai < 2; ++ai)
#pragma unroll
                for (int bj = 0; bj < 2; ++bj)
#pragma unroll
                    for (int n = 0; n < 2; ++n) *(LAS f32x4*)(halo + ((2 * ai + wr) * 2 + (fr - 14)) * 256 + bj * 128 + ccol + 4 * n) = acc[ai][bj][3][n];
        }
        if (!samp) {
        } else if (fr >= 14) {
#pragma unroll
            for (int ai = 0; ai < 2; ++ai)
#pragma unroll
                for (int m = 0; m < 4; ++m) {
                    const int s = (rbase + 128 * ai + 16 * m - NP) >> 4;
#pragma unroll
                    for (int bj = 0; bj < 2; ++bj)
#pragma unroll
                        for (int n = 0; n < 2; ++n) *(f32x4*)(offs + (unsigned)((s * 2 + (fr - 14)) * UPW + bj * DFF + u.pn * 128 + ccol + 4 * n)) = acc[ai][bj][m][n];
                }
        }
        asm volatile("s_waitcnt lgkmcnt(0)" ::: "memory"); __builtin_amdgcn_s_barrier(); asm volatile("" ::: "memory");
        const LAS float* wl_ = (const LAS float*)(lds + EXTRA_OFF + X_W) + (ui & 1) * 1024;
        const int lo2 = u.pad + 2, mb = ((lo2 + 2044) >> 11) << 11; const bool bnd = mb <= lo2 + 255;
        if (samp) conv_act<true, false>(acc, u, wr, fr, rbase, ccol, halo, wl_); else if (bnd) conv_act<false, true>(acc, u, wr, fr, rbase, ccol, halo, wl_); else conv_act<false, false>(acc, u, wr, fr, rbase, ccol, halo, wl_);
    }
    template <bool SAMP, bool BND>
    __device__ __forceinline__ void conv_act(const f32x4 (&acc)[2][2][4][2], const Unit& u, int wr, int fr, int rbase, int ccol, LAS float* halo, const LAS float* wl_) const {
        unsigned char* wsb = (unsigned char*)karg(20);
        bf16_t* ACT = (bf16_t*)(wsb + WS_ACT); const float* sffn = karg(5) + (size_t)l * SB * 2 * UPW; float* offp = (float*)karg(19) + O_FP + (size_t)l * NB * 2 * UPW;
        u32x2 keep[2][4];
#pragma unroll
        for (int n = 0; n < 2; ++n) {
            f32x4 W0[2], W1[2], W2[2], BB[2];
#pragma unroll
            for (int bj = 0; bj < 2; ++bj) {
                const int tc = bj * 128 + ccol + 4 * n;
                W0[bj] = *(const LAS f32x4*)(wl_ + tc); W1[bj] = *(const LAS f32x4*)(wl_ + 256 + tc); W2[bj] = *(const LAS f32x4*)(wl_ + 512 + tc); BB[bj] = *(const LAS f32x4*)(wl_ + 768 + tc);
            }
#pragma unroll
            for (int ai = 0; ai < 2; ++ai)
#pragma unroll
                for (int m = 0; m < 4; ++m) {
                    const int row = rbase + 128 * ai + 16 * m + fr;
                    const bool ok = SAMP || (row < NP && !(ai == 0 && m == 0 && wr == 0 && fr < 2));
                    const int t4 = (row + 2) & 2047;
                    const float z1 = (BND && t4 == 2) ? 0.f : 1.f, z2 = (BND && (t4 == 2 || t4 == 3)) ? 0.f : 1.f;
                    f32x4 a[2];
#pragma unroll
                    for (int bj = 0; bj < 2; ++bj) {
                        f32x4 prev;
                        if (SAMP) { const int s = (rbase + 128 * ai + 16 * m - NP) >> 4; prev = *(const f32x4*)(sffn + (unsigned)((s * 2 + (fr & 1)) * UPW + bj * DFF + u.pn * 128 + ccol + 4 * n)); }
                        else if (m > 0) prev = acc[ai][bj][m > 0 ? m - 1 : 0][n];
                        else { const int blk = 2 * ai + wr; prev = (f32x4){0.f, 0.f, 0.f, 0.f}; if (blk > 0) prev = *(const LAS f32x4*)(halo + ((blk - 1) * 2 + (fr & 1)) * 256 + bj * 128 + ccol + 4 * n); }
                        const f32x4 cur = acc[ai][bj][m][n];
#pragma unroll
                        for (int j = 0; j < 4; ++j) {
                            const float p1 = dppf<0x111>(dppf<0x121>(0.f, prev[j]), cur[j]);
                            const float p2 = dppf<0x112>(dppf<0x122>(0.f, prev[j]), cur[j]);
                            a[bj][j] = BB[bj][j] + W2[bj][j] * cur[j] + W1[bj][j] * (BND ? p1 * z1 : p1) + W0[bj][j] * (BND ? p2 * z2 : p2);
                        }
                        if (BND) { if (ok && t4 < 2 && row >= 2046) *(f32x4*)(offp + (unsigned)(((((row + 2) >> 11) - 1) * 2 + t4) * UPW + bj * DFF + u.pn * 128 + ccol + 4 * n)) = cur; }
                        __builtin_amdgcn_sched_barrier(0);
                    }
                    float o[4];
#pragma unroll
                    for (int j = 0; j < 4; ++j) { const float g = a[0][j], v = a[1][j]; o[j] = g * __builtin_amdgcn_rcpf(1.0f + __builtin_amdgcn_exp2f(-g * LOG2E)) * v; }
                    u32x2 w; w.x = cvt_pk_bf16(o[0], o[1]); w.y = cvt_pk_bf16(o[2], o[3]);
                    if (n == 0) keep[ai][m] = w;
                    else if (ok) { u32x4 w4; w4.x = keep[ai][m].x; w4.y = keep[ai][m].y; w4.z = w.x; w4.w = w.y; *(u32x4*)(ACT + (unsigned)(row * DFF + u.pn * 128 + ccol)) = w4; }
                    __builtin_amdgcn_sched_barrier(0);
                }
        }
    }
};
template <int NQB>
__device__ __forceinline__ void attn_wave(const bf16_t* qp, const bf16_t* kpast, const bf16_t* vpast, int Tpast, const bf16_t* kcur, const bf16_t* vcur, int Tcur, int hd,
                                          int t0, int nvalid_cur, int nq, const LAS float* tbl, bf16_t* outp, const float* gvec, int lane, LAS bf16x8* qlds) {
    const int r = lane & 31, h = lane >> 5;
    constexpr float SC = 0.125f * LOG2E;
#pragma unroll
    for (int qb = 0; qb < NQB; ++qb)
#pragma unroll
        for (int ks = 0; ks < 4; ++ks) qlds[(qb * 4 + ks) * 64 + lane] = *(const bf16x8*)(qp + (size_t)(32 * qb + r) * PW + 16 * ks + 8 * h);
    f32x16 o[2][NQB]; float mrun[NQB], lrun[NQB];
#pragma unroll
    for (int qb = 0; qb < NQB; ++qb) { mrun[qb] = -1e30f; lrun[qb] = 0.f;
#pragma unroll
        for (int db = 0; db < 2; ++db)
#pragma unroll
            for (int i = 0; i < 16; ++i) o[db][qb][i] = 0.f; }
    const float bconst = tbl[191];
    const unsigned vlane = (unsigned)(r * 16 + 8 * h);
    bf16x8 kf[2][4];
#define ATTN_KLOAD(TT) do { const bf16_t* kb_ = (TT) < 8 ? kpast : kcur; const unsigned T0_ = (unsigned)((TT) < 8 ? Tpast + 64 * (TT) : Tcur); \
        _Pragma("unroll") for (int kb = 0; kb < 2; ++kb) { const unsigned T_ = T0_ + 32 * kb + r; const unsigned ko_ = ((T_ >> 5) * 32 + hd * 4) * 512 + (T_ & 31) * 16 + 8 * h; \
            _Pragma("unroll") for (int ks = 0; ks < 4; ++ks) kf[kb][ks] = *(const bf16x8*)(kb_ + ko_ + ks * 512); } } while (0)
    ATTN_KLOAD(t0);
    for (int t = t0; t <= 8; ++t) {
        const bf16_t* vp = t < 8 ? vpast : vcur; const unsigned Tv = (unsigned)(t < 8 ? Tpast + 64 * t : Tcur);
        bf16x8 vf[2][2][2];
#pragma unroll
        for (int kb = 0; kb < 2; ++kb)
#pragma unroll
            for (int sx = 0; sx < 2; ++sx)
#pragma unroll
                for (int db = 0; db < 2; ++db)
                    vf[kb][sx][db] = *(const bf16x8*)(vp + (size_t)(((Tv >> 4) + 2 * kb + sx) * 512 + hd * 64 + 32 * db) * 16 + vlane);
        __builtin_amdgcn_sched_barrier(0);
        const int koff = -512 + 64 * t;
#pragma unroll
        for (int qb = 0; qb < NQB; ++qb) {
            f32x16 s[2];
#pragma unroll
            for (int kb = 0; kb < 2; ++kb)
#pragma unroll
                for (int i = 0; i < 16; ++i) s[kb][i] = 0.f;
#pragma unroll
            for (int ks = 0; ks < 4; ++ks) {
                const bf16x8 qf = qlds[(qb * 4 + ks) * 64 + lane];
                s[0] = __builtin_amdgcn_mfma_f32_32x32x16_bf16(kf[0][ks], qf, s[0], 0, 0, 0);
                s[1] = __builtin_amdgcn_mfma_f32_32x32x16_bf16(kf[1][ks], qf, s[1], 0, 0, 0);
            }
            __builtin_amdgcn_sched_barrier(0);
            if (qb == NQB - 1 && t < 8) {
                ATTN_KLOAD(t + 1);
                __builtin_amdgcn_sched_barrier(0);
            }
            float mx = mrun[qb];
            if (t <= 5) {
#pragma unroll
                for (int kb = 0; kb < 2; ++kb)
#pragma unroll
                    for (int i = 0; i < 16; ++i) { const float v = s[kb][i] * SC + bconst; s[kb][i] = v; mx = fmaxf(mx, v); }
            } else {
                const LAS float* tl = tbl + (32 * qb + r - koff - 4 * h);
#pragma unroll
                for (int kb = 0; kb < 2; ++kb)
#pragma unroll
                    for (int i = 0; i < 16; ++i) {
                        const int kin = 32 * kb + (i & 3) + 8 * (i >> 2);
                        float v = s[kb][i] * SC + tl[63 - kin];
                        if (t == 8 && (kin + 4 * h) >= nvalid_cur) v = -1e30f;
                        s[kb][i] = v; mx = fmaxf(mx, v);
                    }
            }
            mx = fmaxf(mx, __shfl_xor(mx, 32));
            const float alpha = __builtin_amdgcn_exp2f(mrun[qb] - mx); mrun[qb] = mx;
            float ps = 0.f;
#pragma unroll
            for (int kb = 0; kb < 2; ++kb)
#pragma unroll
                for (int i = 0; i < 16; ++i) { const float p = __builtin_amdgcn_exp2f(s[kb][i] - mx); s[kb][i] = p; ps += p; }
            lrun[qb] = lrun[qb] * alpha + ps;
#pragma unroll
            for (int db = 0; db < 2; ++db)
#pragma unroll
                for (int i = 0; i < 16; ++i) o[db][qb][i] *= alpha;
#pragma unroll
            for (int kb = 0; kb < 2; ++kb)
#pragma unroll
                for (int sx = 0; sx < 2; ++sx) {
                    u32x4 w; const f32x16& sv = s[kb];
                    w.x = cvt_pk_bf16(sv[8 * sx + 0], sv[8 * sx + 1]); w.y = cvt_pk_bf16(sv[8 * sx + 2], sv[8 * sx + 3]);
                    w.z = cvt_pk_bf16(sv[8 * sx + 4], sv[8 * sx + 5]); w.w = cvt_pk_bf16(sv[8 * sx + 6], sv[8 * sx + 7]);
                    const bf16x8 pf = __builtin_bit_cast(bf16x8, w);
#pragma unroll
                    for (int db = 0; db < 2; ++db) o[db][qb] = __builtin_amdgcn_mfma_f32_32x32x16_bf16(vf[kb][sx][db], pf, o[db][qb], 0, 0, 0);
                }
            __builtin_amdgcn_sched_barrier(0);
        }
    }
    int lane2 = lane; asm volatile("" : "+v"(lane2));
    const int r2 = lane2 & 31, h2 = lane2 >> 5;
#pragma unroll
    for (int qb = 0; qb < NQB; ++qb) {
        float l = lrun[qb]; l += __shfl_xor(l, 32);
        const float inv = 1.0f / l; float ss = 0.f;
#pragma unroll
        for (int db = 0; db < 2; ++db)
#pragma unroll
            for (int i = 0; i < 16; ++i) { const float v = o[db][qb][i] * inv; o[db][qb][i] = v; ss += v * v; }
        ss += __shfl_xor(ss, 32);
        const float rn = rsqrtf(ss * (1.0f / 64.0f) + EPS);
        const int q = 32 * qb + r2;
#pragma unroll
        for (int db = 0; db < 2; ++db) {
            u32x2 pk[4];
#pragma unroll
            for (int g4 = 0; g4 < 4; ++g4) {
                pk[g4].x = cvt_pk_bf16(o[db][qb][4 * g4 + 0] * rn, o[db][qb][4 * g4 + 1] * rn);
                pk[g4].y = cvt_pk_bf16(o[db][qb][4 * g4 + 2] * rn, o[db][qb][4 * g4 + 3] * rn);
            }
#pragma unroll
            for (int k = 0; k < 2; ++k) {
                const u32x2 lo = pk[2 * k], hi = pk[2 * k + 1];
                const u32x2 snd = h2 ? lo : hi;
                u32x2 rcv; rcv.x = (unsigned)__shfl_xor((int)snd.x, 32); rcv.y = (unsigned)__shfl_xor((int)snd.y, 32);
                u32x4 w;
                if (h2) { w.x = rcv.x; w.y = rcv.y; w.z = hi.x; w.w = hi.y; } else { w.x = lo.x; w.y = lo.y; w.z = rcv.x; w.w = rcv.y; }
                if (q < nq) *(u32x4*)(outp + (unsigned)(q * DM + 32 * db + 16 * k + 8 * h2)) = w;
            }
        }
    }
}

__device__ __forceinline__ void unp8(const u32x4 w, float (&v)[8]) {
    v[0] = __builtin_bit_cast(float, w.x << 16); v[1] = __builtin_bit_cast(float, w.x & 0xffff0000u);
    v[2] = __builtin_bit_cast(float, w.y << 16); v[3] = __builtin_bit_cast(float, w.y & 0xffff0000u);
    v[4] = __builtin_bit_cast(float, w.z << 16); v[5] = __builtin_bit_cast(float, w.z & 0xffff0000u);
    v[6] = __builtin_bit_cast(float, w.w << 16); v[7] = __builtin_bit_cast(float, w.w & 0xffff0000u);
}
__device__ __forceinline__ void ld8(const bf16_t* p, float (&v)[8]) {
    const u32x4 w = *(const u32x4*)p;
    v[0] = __builtin_bit_cast(float, w.x << 16); v[1] = __builtin_bit_cast(float, w.x & 0xffff0000u);
    v[2] = __builtin_bit_cast(float, w.y << 16); v[3] = __builtin_bit_cast(float, w.y & 0xffff0000u);
    v[4] = __builtin_bit_cast(float, w.z << 16); v[5] = __builtin_bit_cast(float, w.z & 0xffff0000u);
    v[6] = __builtin_bit_cast(float, w.w << 16); v[7] = __builtin_bit_cast(float, w.w & 0xffff0000u);
}
__device__ __forceinline__ void conv_run(int run, const bf16_t* P5, bf16_t* MIX, const float* cw, const float* cg_, const float* smix, float* ocp, float* ocs, int lane) {
    const int R0 = run * 16, c0 = 8 * lane;
    float w0[8], w1[8], w2[8], gg[8], h0[8], h1[8];
#pragma unroll
    for (int j = 0; j < 8; ++j) { w0[j] = cw[c0 + j]; w1[j] = cw[512 + c0 + j]; w2[j] = cw[1024 + c0 + j]; gg[j] = cg_[c0 + j]; }
    const bool samp = R0 >= NP;
    if (samp) { const int s = (R0 - NP) >> 4;
#pragma unroll
        for (int j = 0; j < 8; ++j) { h0[j] = smix[(size_t)(s * 2 + 0) * 512 + c0 + j]; h1[j] = smix[(size_t)(s * 2 + 1) * 512 + c0 + j]; }
    } else if ((R0 & 2047) == 0) {
#pragma unroll
        for (int j = 0; j < 8; ++j) { h0[j] = 0.f; h1[j] = 0.f; }
    } else {
        ld8(P5 + (size_t)(R0 - 2) * PW + 1536 + c0, h0);
        ld8(P5 + (size_t)(R0 - 1) * PW + 1536 + c0, h1);
    }
    for (int i0 = 0; i0 < 16; i0 += 8) {
        u32x4 rb[8], rc[8];
#pragma unroll
        for (int k = 0; k < 8; ++k) { const bf16_t* rp = P5 + (size_t)(R0 + i0 + k) * PW + c0; rb[k] = *(const u32x4*)(rp + 1024); rc[k] = *(const u32x4*)(rp + 1536); }
#pragma unroll
        for (int k = 0; k < 8; ++k) {
            float bv[8], cv[8], z[8];
            unp8(rb[k], bv); unp8(rc[k], cv);
            float ss = 0.f;
#pragma unroll
            for (int j = 0; j < 8; ++j) { const float cu = cv[j]; z[j] = bv[j] * (w0[j] * h0[j] + w1[j] * h1[j] + w2[j] * cu); ss += z[j] * z[j]; h0[j] = h1[j]; h1[j] = cu; }
            ss += __shfl_xor(ss, 1); ss += __shfl_xor(ss, 2); ss += __shfl_xor(ss, 4);
            const float rn = rsqrtf(ss * (1.0f / 64.0f) + EPS);
                u32x4 w; w.x = cvt_pk_bf16(z[0] * rn, z[1] * rn); w.y = cvt_pk_bf16(z[2] * rn, z[3] * rn);
            w.z = cvt_pk_bf16(z[4] * rn, z[5] * rn); w.w = cvt_pk_bf16(z[6] * rn, z[7] * rn);
            *(u32x4*)(MIX + (size_t)(R0 + i0 + k) * DM + 512 + c0) = w;
        }
    }
    float* op = nullptr;
    if (samp) op = ocs + (size_t)((R0 - NP) >> 4) * 1024;
    else if (((R0 + 16) & 2047) == 0) op = ocp + (size_t)(R0 >> 11) * 1024;
    if (op) {
#pragma unroll
        for (int j = 0; j < 8; ++j) { op[c0 + j] = h0[j]; op[512 + c0 + j] = h1[j]; }
    }
}

__device__ __forceinline__ unsigned f2bf(float f) { unsigned u = __builtin_bit_cast(unsigned, f); return (u + 0x7fffu + ((u >> 16) & 1u)) >> 16; }
__device__ __forceinline__ unsigned pk2(float lo, float hi) { return f2bf(lo) | (f2bf(hi) << 16); }
__device__ __forceinline__ void transpose_item(const float* W, int N, int k0, int n0, bf16_t* dst, int ldd, LAS float* scr, int lane, const float* gk = nullptr) {
#pragma unroll 8
    for (int i = 0; i < 32; ++i) { const int kk = 2 * i + (lane >> 5); scr[kk * 33 + (lane & 31)] = W[(size_t)(k0 + kk) * N + n0 + (lane & 31)] * (gk ? gk[k0 + kk] : 1.0f); }
    asm volatile("s_waitcnt lgkmcnt(0)" ::: "memory");
    const int c = lane & 7;
#pragma unroll
    for (int j = 0; j < 4; ++j) { const int n = (lane >> 3) + 8 * j; const LAS float* s = scr + (8 * c) * 33 + n;
        u32x4 o; o.x = pk2(s[0 * 33], s[1 * 33]); o.y = pk2(s[2 * 33], s[3 * 33]); o.z = pk2(s[4 * 33], s[5 * 33]); o.w = pk2(s[6 * 33], s[7 * 33]);
        *(u32x4*)(dst + (size_t)n * ldd + k0 + 8 * c) = o; }
    asm volatile("s_waitcnt lgkmcnt(0)" ::: "memory");
}

__device__ __forceinline__ void transpose_item_v(const float* W, int k0, int n0, bf16_t* dst, int Tbase, LAS float* scr, int lane) {
#pragma unroll 8
    for (int i = 0; i < 32; ++i) { const int kk = 2 * i + (lane >> 5); scr[kk * 33 + (lane & 31)] = W[(size_t)(k0 + kk) * 512 + n0 + (lane & 31)]; }
    asm volatile("s_waitcnt lgkmcnt(0)" ::: "memory");
    const int c = lane & 7;
#pragma unroll
    for (int j = 0; j < 4; ++j) { const int n = (lane >> 3) + 8 * j; const LAS float* s = scr + (8 * c) * 33 + n;
        u32x2 o0, o1; o0.x = pk2(s[0 * 33], s[1 * 33]); o0.y = pk2(s[2 * 33], s[3 * 33]); o1.x = pk2(s[4 * 33], s[5 * 33]); o1.y = pk2(s[6 * 33], s[7 * 33]);
        const unsigned T = (unsigned)(Tbase + k0 + 8 * c);
        const unsigned vb = ((T >> 4) * 512 + (unsigned)(n0 + n)) * 16 + 4 * ((T >> 3) & 1);
        *(u32x2*)(dst + vb) = o0; *(u32x2*)(dst + vb + 8) = o1; }
    asm volatile("s_waitcnt lgkmcnt(0)" ::: "memory");
}
#define XB_TMO      128
#define XB_XCNT(j)  (256  + 64 * (j))
#define XB_XSUB(j)  (1280 + 64 * (j))
#define XB_XGEN(j)  (2304 + 64 * (j))
#define XB_TOP      3328
#define XB_TOPGEN   3392
#define XCD_BAR_WORDS 3456
#define XB_SPIN_CAP (1u << 18)

__device__ __forceinline__ unsigned xb_ld(unsigned* p)              { return __hip_atomic_load(p, __ATOMIC_RELAXED, __HIP_MEMORY_SCOPE_AGENT); }
__device__ __forceinline__ unsigned xb_add(unsigned* p, unsigned v) { return __hip_atomic_fetch_add(p, v, __ATOMIC_RELAXED, __HIP_MEMORY_SCOPE_AGENT); }
__device__ __forceinline__ unsigned xb_xcc_id() { return (unsigned)__builtin_amdgcn_s_getreg((3 << 11) | 20) & 0xFu; }
#define XB_SPIN(cond, bar) do { unsigned _sp = 0; while (cond) { __builtin_amdgcn_s_sleep(1); \
    if ((++_sp & 255u) == 0u) { if (xb_ld(&(bar)[XB_TMO])) break; if (_sp > XB_SPIN_CAP) { atomicAdd(&(bar)[XB_TMO], 1u); break; } } } } while (0)

struct XcdBarrier {
    unsigned* bar; unsigned x;
    volatile LAS unsigned* st;
};

__device__ __forceinline__ XcdBarrier xcd_barrier_post(unsigned* bar, volatile LAS unsigned* st) {
    XcdBarrier b; b.bar = bar; b.x = xb_xcc_id(); b.st = st;
    if (threadIdx.x == 0) (void)xb_add(&bar[XB_XCNT(b.x)], 1u);
    return b;
}
__device__ __forceinline__ void xcd_barrier_complete(unsigned* bar, unsigned x, unsigned& nloc, unsigned& nx) {
    const unsigned G = gridDim.x * gridDim.y * gridDim.z;
    unsigned sum, cnt, mine, sp = 0u;
    for (;;) {
        sum = 0u; cnt = 0u; mine = 0u;
#pragma unroll
        for (unsigned j = 0; j < 16; ++j) { const unsigned c = xb_ld(&bar[XB_XCNT(j)]); sum += c; cnt += (c > 0u) ? 1u : 0u; mine = (j == x) ? c : mine; }
        if (sum == G) break;
        __builtin_amdgcn_s_sleep(1);
        if ((++sp & 255u) == 0u) { if (xb_ld(&bar[XB_TMO])) break; if (sp > XB_SPIN_CAP) { atomicAdd(&bar[XB_TMO], 1u); break; } }
    }
    nloc = mine > 0u ? mine : 1u; nx = cnt > 0u ? cnt : 1u;
}

__device__ __forceinline__ void xcd_barrier(const XcdBarrier& b) {
    asm volatile("s_waitcnt vmcnt(0)" ::: "memory");
    __syncthreads();
    int t_o = threadIdx.x; asm volatile("" : "+v"(t_o));
    if (t_o == 0) {
        unsigned* bar = b.bar;
        __builtin_amdgcn_s_waitcnt(0);
        unsigned nloc = b.st[0], nx = b.st[1];
        if (nloc == 0u) { xcd_barrier_complete(bar, b.x, nloc, nx); b.st[0] = nloc; b.st[1] = nx; }
        const unsigned old = xb_add(&bar[XB_XSUB(b.x)], 1u);
        const unsigned gen = old / nloc;
        if (old + 1u == (gen + 1u) * nloc) {
            __builtin_amdgcn_fence(__ATOMIC_RELEASE, "agent");
            asm volatile("s_waitcnt vmcnt(0)" ::: "memory");
            const unsigned og = xb_add(&bar[XB_TOP], 1u);
            const unsigned tg = og / nx;
            if (og + 1u == (tg + 1u) * nx) xb_add(&bar[XB_TOPGEN], 1u);
            else XB_SPIN(xb_ld(&bar[XB_TOPGEN]) == tg, bar);
            __builtin_amdgcn_fence(__ATOMIC_ACQUIRE, "agent");
            xb_add(&bar[XB_XGEN(b.x)], 1u);
            asm volatile("s_waitcnt vmcnt(0)" ::: "memory");
        } else {
            XB_SPIN(xb_ld(&bar[XB_XGEN(b.x)]) == gen, bar);
            __builtin_amdgcn_fence(__ATOMIC_ACQUIRE, "agent");
            asm volatile("s_waitcnt vmcnt(0)" ::: "memory");
        }
    }
    __syncthreads();
}

struct Args { const float* in[19]; float* out; unsigned char* ws; };

__global__ void __launch_bounds__(512, 2) fwd_mega(Args args) {
    extern __shared__ __attribute__((aligned(16))) unsigned char lds_raw[];
    LAS unsigned char* const lds0 = (LAS unsigned char*)lds_raw;
    cg::grid_group grid = cg::this_grid();
    volatile LAS unsigned* barst = (volatile LAS unsigned*)(lds0 + EXTRA_OFF + X_BAR);
    if (threadIdx.x < 2) barst[threadIdx.x] = 0u;
    __syncthreads();
    (void)xcd_barrier_post((unsigned*)((unsigned char*)karg(20) + WS_CTL + 4096), barst);
#define GRID_BARRIER() do { XcdBarrier b_; b_.bar = (unsigned*)((unsigned char*)karg(20) + WS_CTL + 4096); b_.x = xb_xcc_id(); b_.st = (volatile LAS unsigned*)(lds0 + EXTRA_OFF + X_BAR); xcd_barrier(b_); } while (0)
    const int G = gridDim.x, bx = blockIdx.x, NGW = G * 8;
#define out ((float*)karg(19))
#define x_prompt (karg(0))
#define x_sample (karg(1))
#define cache_k (karg(2))
#define cache_v (karg(3))
#define st_mix (karg(4))
#define st_ffn (karg(5))
#define ln1 (karg(6))
#define w_in (karg(7))
#define rel_table (karg(8))
#define conv_w (karg(9))
#define attn_g (karg(10))
#define conv_g (karg(11))
#define w_out (karg(12))
#define ln2 (karg(13))
#define w_up (karg(14))
#define fconv_w (karg(15))
#define fconv_b (karg(16))
#define w_down (karg(17))
#define final_norm (karg(18))
#define X out
#define ctr ((unsigned*)(ws + WS_CTL))
#define XG ((bf16_t*)(ws + WS_XG))
#define SSQ ((float*)(ws + WS_SSQ))
#define P5 ((bf16_t*)(ws + WS_P5))
#define VT ((bf16_t*)(ws + WS_VT))
#define ACT ((bf16_t*)(ws + WS_ACT))
#define MIX ((bf16_t*)(ws + WS_MIX))
#define KC ((bf16_t*)(ws + WS_KC))
#define VCT ((bf16_t*)(ws + WS_VCT))
#define FIRST ((float*)(ws + WS_FIRST))
#define LAST ((float*)(ws + WS_LAST))
#define KFB ((bf16_t*)(ws + WS_KF))
#define CACHE_CONVERT(LL, WIDX, NW) do { \
            const float* ck = cache_k + (size_t)(LL) * SB * 512 * 512; const float* cv = cache_v + (size_t)(LL) * SB * 512 * 512; \
            for (size_t i = (size_t)((WIDX) * 512 + tid) * 4; i < (size_t)SB * 512 * 512; i += (size_t)(NW) * 512 * 4) { \
                const f32x4 v = *(const f32x4*)(ck + i); u32x2 w; w.x = cvt_pk_bf16(v[0], v[1]); w.y = cvt_pk_bf16(v[2], v[3]); \
                const unsigned T_ = (unsigned)(i >> 9), c_ = (unsigned)(i & 511), hh_ = c_ >> 6, d_ = c_ & 63; \
                *(u32x2*)(KC + (((((T_ >> 5) * 8 + hh_) * 4 + (d_ >> 4)) * 32 + (T_ & 31)) * 16 + (d_ & 15))) = w; } \
            for (int it = (WIDX) * 8 + wave; it < SB * 128; it += (NW) * 8) { const int s_ = it >> 7, r_ = it & 127, kb_ = r_ >> 4, nb_ = r_ & 15; \
                transpose_item_v(cv + (size_t)s_ * 512 * 512, 64 * kb_, 32 * nb_, VCT, s_ * 512, scr, lane); } \
        } while (0)
#define PHASE_BEGIN int tid = threadIdx.x; asm volatile("" : "+v"(tid)); const int lane = tid & 63; const int wave = __builtin_amdgcn_readfirstlane(tid >> 6); int bxp = blockIdx.x; asm volatile("" : "+s"(bxp)); (void)bxp; const int gw = bx * 8 + wave; \
    unsigned char* ws = (unsigned char*)karg(20); unsigned ldsv = (unsigned)(size_t)lds0; asm volatile("" : "+s"(ldsv)); LAS unsigned char* lds = (LAS unsigned char*)(size_t)ldsv; LAS float* scr = (LAS float*)(lds + wave * 16384); (void)lane; (void)gw; (void)scr;

#if PH & 1
    {   PHASE_BEGIN
    if (bx == 0 && tid < 16) ctr[tid] = 0u;
        constexpr int I_IN = 16 * 96, I_OUT = 16 * 32, I_UP = 16 * 176, I_DN = 44 * 32, I_L = I_IN + I_OUT + I_UP + I_DN;
        for (int it = gw; it < DEPTH * I_L; it += NGW) {
            const int l = it / I_L; int r = it % I_L; unsigned char* wl = ws + WS_W + (size_t)l * W_LAYER;
            if (r < I_IN) { const int kb = r / 96, nb = r % 96, n0 = 32 * nb; const int drow = n0 < 1024 ? n0 : (n0 < 1536 ? 2560 + n0 - 1024 : (n0 < 2048 ? n0 - 512 : (n0 < 2560 ? 1536 + ((n0 - 2048) >> 7) * 256 + ((n0 - 2048) & 127) : 1536 + ((n0 - 2560) >> 7) * 256 + 128 + ((n0 - 2560) & 127))));
                transpose_item(w_in + (size_t)l * DM * PROJ, PROJ, 64 * kb, n0, (bf16_t*)(wl + W_IN) + (size_t)drow * 1024, 1024, scr, lane, ln1 + (size_t)l * DM); continue; }
            r -= I_IN;
            if (r < I_OUT) { const int kb = r / 32, nb = r % 32, n0 = 32 * nb;
                transpose_item(w_out + (size_t)l * DM * DM, DM, 64 * kb, n0, (bf16_t*)(wl + W_OUT) + (size_t)n0 * 1024, 1024, scr, lane, kb < 8 ? attn_g + (size_t)l * 512 : conv_g + (size_t)l * 512 - 512); continue; }
            r -= I_OUT;
            if (r < I_UP) { const int kb = r / 176, nb = r % 176, n0 = 32 * nb; const int bj = n0 / DFF, ch = n0 % DFF; const int drow = (ch >> 7) * 256 + bj * 128 + (ch & 127);
                transpose_item(w_up + (size_t)l * DM * UPW, UPW, 64 * kb, n0, (bf16_t*)(wl + W_UP) + (size_t)drow * 1024, 1024, scr, lane, ln2 + (size_t)l * DM); continue; }
            r -= I_UP;
            { const int kb = r / 32, nb = r % 32, n0 = 32 * nb;
                transpose_item(w_down + (size_t)l * DFF * DM, DM, 64 * kb, n0, (bf16_t*)(wl + W_DOWN) + (size_t)n0 * DFF, DFF, scr, lane); }
        }
        {
            for (int row0 = gw; row0 < M; row0 += 8 * NGW) {
                f32x4 xv[8][4];
#pragma unroll
                for (int k = 0; k < 8; ++k) { const int row = row0 + k * NGW; if (row < M) { const float* xr = row < NP ? x_prompt + (size_t)row * DM : x_sample + (size_t)(row - NP) * DM;
#pragma unroll
                    for (int j = 0; j < 4; ++j) xv[k][j] = *(const f32x4*)(xr + 4 * lane + 256 * j); } }
#pragma unroll
                for (int k = 0; k < 8; ++k) { const int row = row0 + k * NGW; if (row < M) {
                    float ss = 0.f;
#pragma unroll
                    for (int j = 0; j < 4; ++j) {
                        const f32x4 v = xv[k][j];
                        ss += (v[0] * v[0] + v[1] * v[1]) + (v[2] * v[2] + v[3] * v[3]);
                        u32x2 w; w.x = cvt_pk_bf16(v[0], v[1]); w.y = cvt_pk_bf16(v[2], v[3]);
                        *(u32x2*)(XG + (size_t)row * DM + 4 * lane + 256 * j) = w;
                    }
#pragma unroll
                    for (int o = 1; o < 64; o <<= 1) ss += __shfl_xor(ss, o);
                    if (lane == 0) *(f32x4*)(SSQ + (size_t)row * 4) = (f32x4){ss, 0.f, 0.f, 0.f};
                } }
            }
        }
        CACHE_CONVERT(0, bx, G);
    }
#endif
    GRID_BARRIER();
    if (gridDim.x == 0x7fffffffu) grid.sync();

    for (int l = 0; l < DEPTH; ++l) {
#define wl (ws + WS_W + (size_t)l * W_LAYER)
#if PH & 2
        {
            PHASE_BEGIN
            SchedIn S{(const char*)XG, (const char*)(wl + W_IN), (const char*)(wl + W_IN) + (size_t)2560 * 2048, G, bxp, (l * 4 + 0) * 64};
            EpiIn E{l};
            pg8::gemm_phase<EpiIn, SchedIn, true, true>(lds, 1024, S, E);
        }
#endif
        GRID_BARRIER();
#if PH & 4
        {
            PHASE_BEGIN
            LAS float* T = (LAS float*)lds;
            for (int i = tid; i < 8 * 256; i += 512) { const int hh = i >> 8, j = i & 255; int rel = j - 63; rel = rel > 128 ? 128 : rel; T[hh * 256 + j] = rel_table[(size_t)l * 8 * 257 + hh * 257 + rel + 128] * LOG2E; }
            __syncthreads();
            for (int run = gw; run < M / 16; run += NGW)
                conv_run(run, P5, MIX, conv_w + (size_t)l * 3 * 512, conv_g + (size_t)l * 512, st_mix + (size_t)l * SB * 2 * 512, out + O_CP + (size_t)l * NB * 2 * 512, out + O_CS + (size_t)l * SB * 2 * 512, lane);
            LAS int* qslot = (LAS int*)(lds + EXTRA_OFF + 8192);
            const int hd = wave;
            for (;;) {
                __syncthreads();
                if (tid == 0) *qslot = (int)atomicAdd(ctr + 16 + l * 8 + (bx & 7), 1u);
                __syncthreads();
                const int v = *qslot;
                if (v >= 68) break;
                int ln = threadIdx.x & 63; asm volatile("" : "+v"(ln));
                const int xg = bx & 7;
                int b = 0, c = 0, s = -1;
                if (v < 48) { b = 2 * xg + v / 24; c = 8 + v % 24; }
                else if (v < 56) { const int k = v - 48; c = 7 - (k >> 1); b = 2 * xg + (k & 1); }
                else if (v < 60) { s = 4 * xg + (v - 56); }
                else { const int k = v - 60; c = 3 - (k >> 1); b = 2 * xg + (k & 1); }
                {
                    const bool smp = s >= 0;
                    const int row0 = smp ? NP + s * SS : b * SEQ + c * 64;
                    attn_wave<2>(P5 + (size_t)row0 * PW + hd * 64, smp ? KC : KFB, smp ? VCT : VT, smp ? s * 512 : row0 - 512, KFB, VT, row0, hd,
                                 (smp || c >= 8) ? 0 : 8 - c, smp ? SS : 64, smp ? SS : 64,
                                 T + hd * 256, MIX + (size_t)row0 * DM + hd * 64, attn_g + (size_t)l * 512 + hd * 64, ln, (LAS bf16x8*)(lds + 16384 + wave * 8192));
                }
            }
        }
#endif
        GRID_BARRIER();
#if PH & 8
        {
            PHASE_BEGIN
            SchedGemm S{(const char*)MIX, (const char*)(wl + W_OUT), 4, G, bxp, 16, 1, (l * 4 + 1) * 64, TSTEP1K};
            EpiRes E{XG, SSQ + (1u << 18)};
            pg8::gemm_phase<EpiRes, SchedGemm, true, true>(lds, 1024, S, E);
        }
#endif
        GRID_BARRIER();
#if PH & 16
        {
            PHASE_BEGIN
            SchedUp S{(const char*)XG, (const char*)(wl + W_UP), G, bxp, 0};
            EpiUp E{l};
            pg8::gemm_phase<EpiUp, SchedUp, true, true>(lds, 1024, S, E);
        }
#endif
        GRID_BARRIER();
#if PH & 64
        {
            PHASE_BEGIN
            SchedGemm S{(const char*)ACT, (const char*)(wl + W_DOWN), 4, G, bxp, 44, 2, (l * 4 + 3) * 64, (size_t)256 * DFF * 2};
            EpiRes E{XG, SSQ};
            pg8::gemm_phase<EpiRes, SchedGemm, true, true>(lds, DFF, S, E);
            { int bxo = blockIdx.x; asm volatile("" : "+s"(bxo)); if (l + 1 < DEPTH && bxo >= 16) { CACHE_CONVERT(l + 1, bxo - 16, G - 16); } }
        }
#endif
        GRID_BARRIER();
    }
    PHASE_BEGIN
    {
        f32x4 fg[4];
#pragma unroll
        for (int j = 0; j < 4; ++j) fg[j] = *(const f32x4*)(final_norm + 4 * lane + 256 * j);
        for (int row0 = gw; row0 < M; row0 += 8 * NGW) {
            u32x2 xw[8][4]; f32x4 pp[8];
#pragma unroll
            for (int k = 0; k < 8; ++k) { const int row = row0 + k * NGW; if (row < M) { pp[k] = *(const f32x4*)(SSQ + (size_t)row * 4);
#pragma unroll
                for (int j = 0; j < 4; ++j) xw[k][j] = *(const u32x2*)(XG + (size_t)row * DM + 4 * lane + 256 * j); } }
#pragma unroll
            for (int k = 0; k < 8; ++k) { const int row = row0 + k * NGW; if (row < M) { const float rs = rstd_of(pp[k]);
#pragma unroll
                for (int j = 0; j < 4; ++j) { const u32x2 w = xw[k][j]; f32x4 v; v[0] = __builtin_bit_cast(float, w.x << 16); v[1] = __builtin_bit_cast(float, w.x & 0xffff0000u); v[2] = __builtin_bit_cast(float, w.y << 16); v[3] = __builtin_bit_cast(float, w.y & 0xffff0000u);
                    *(f32x4*)(X + (size_t)row * DM + 4 * lane + 256 * j) = v * rs * fg[j]; } } }
        }
    }
}

#undef out
#undef X
#undef ctr
#undef wl
extern "C" void kernel_launch(void* const* d_in, const int* in_sizes, int n_in, void* d_out, int out_size, void* d_ws, size_t ws_size, hipStream_t stream) {
    static int grid = 0;
    if (grid == 0) {
        if (n_in != 19 || ws_size < WS_END) { fprintf(stderr, "kernel_launch: unexpected n_in %d / ws_size %zu (need %zu)\n", n_in, ws_size, (size_t)WS_END); grid = -1; return; }
        int dev = 0, cus = 0, per_cu = 0;
        hipGetDevice(&dev); hipDeviceGetAttribute(&cus, hipDeviceAttributeMultiprocessorCount, dev);
        if (hipFuncSetAttribute((const void*)fwd_mega, hipFuncAttributeMaxDynamicSharedMemorySize, LDS_BYTES) != hipSuccess) { fprintf(stderr, "kernel_launch: hipFuncSetAttribute failed\n"); grid = -1; return; }
        if (hipOccupancyMaxActiveBlocksPerMultiprocessor(&per_cu, (const void*)fwd_mega, 512, LDS_BYTES) != hipSuccess || per_cu < 1) { fprintf(stderr, "kernel_launch: occupancy query says %d\n", per_cu); per_cu = 1; }
        (void)hipGetLastError();
        grid = cus * 1;
    }
    if (grid < 0) return;
    if (hipMemsetAsync((char*)d_ws + WS_CTL, 0, 65536, stream) != hipSuccess) { fprintf(stderr, "kernel_launch: memset failed\n"); return; }
    Args a{};
    for (int i = 0; i < 19; ++i) a.in[i] = (const float*)d_in[i];
    a.out = (float*)d_out; a.ws = (unsigned char*)d_ws;
    void* kargs[] = {&a};
    hipError_t e = hipLaunchCooperativeKernel((const void*)fwd_mega, dim3(grid), dim3(512), kargs, LDS_BYTES, stream);
    if (e != hipSuccess) fprintf(stderr, "cooperative launch failed: %s (grid %d)\n", hipGetErrorString(e), grid);
}
```
